# Optimizing an MI355X kernel written in HIP

```python
import math
import jax, jax.numpy as jnp
from jax import lax
import numpy as np

D_MODEL = 2048
BATCH = 1
SEQ = 8192
DEPTH = 1

N_META = 16
D_FF = 5632
EPS = 1e-6
HG_HEADS = 12
HG_DK = 128
HG_DV = 128
HG_K = HG_HEADS * HG_DK
HG_WIDTH = HG_HEADS * HG_DV
HG_CHUNK = 64
S5_GROUP = 16
S5_GROUPS = 32
S5_WIDTH = S5_GROUP * S5_GROUPS
S5_STATE = 64
DT_MIN = 1e-3
DT_MAX = 1e-1
IN_COLS = 3 * HG_K + HG_WIDTH + S5_WIDTH + 2 * D_MODEL

kernel_name = "hybrid_hgrn2_s5_macaron_meta"


def _rms_norm(x, g):
    xf = x.astype(jnp.float32)
    y = xf * lax.rsqrt(jnp.mean(xf * xf, axis=-1, keepdims=True) + EPS)
    return (y * g.astype(jnp.float32)).astype(x.dtype)


def _swiglu(x, w_gate, w_up, w_down):
    return (jax.nn.silu(x @ w_gate) * (x @ w_up)) @ w_down


def _split_points():
    sizes = (HG_K, HG_K, HG_WIDTH, HG_WIDTH, S5_WIDTH, D_MODEL)
    return [int(v) for v in np.cumsum(sizes)]


def _hgrn2_chunkwise(q, logf, k, v):
    B, L, H, DK = q.shape
    DV = v.shape[-1]
    n = L // HG_CHUNK

    def to_chunks(a):
        return a.reshape(B, n, HG_CHUNK, H, a.shape[-1]).swapaxes(0, 1)

    causal = jnp.tril(jnp.ones((HG_CHUNK, HG_CHUNK), bool))[None, :, :, None, None]

    def step(S, inp):
        qi, gi, ki, vi = inp
        b = jnp.cumsum(gi, axis=1)
        b_last = b[:, -1]
        o_inter = jnp.einsum('bthk,bhkv->bthv', qi * jnp.exp(b), S)
        diff = b[:, :, None] - b[:, None, :]
        decay = jnp.exp(jnp.where(causal, diff, -jnp.inf))
        attn = jnp.einsum('bthk,bshk,btshk->btsh', qi, ki, decay)
        o_intra = jnp.einsum('btsh,bshv->bthv', attn, vi)
        k_dec = ki * jnp.exp(b_last[:, None] - b)
        S_new = jnp.exp(b_last)[..., None] * S + jnp.einsum('bchk,bchv->bhkv', k_dec, vi)
        return S_new, o_inter + o_intra

    S0 = jnp.zeros((B, H, DK, DV), jnp.float32)
    _, o = lax.scan(step, S0, tuple(map(to_chunks, (q, logf, k, v))))
    return o.swapaxes(0, 1).reshape(B, L, H, DV)


def _s5_scan(u, lam_re, lam_im, log_step, b_re, b_im, c_re, c_im, d_skip):
    f32 = jnp.float32
    lr, li = lam_re.astype(f32), lam_im.astype(f32)
    dt = jnp.exp(log_step.astype(f32))[:, None]
    mag = jnp.exp(lr * dt)
    abar_re, abar_im = mag * jnp.cos(li * dt), mag * jnp.sin(li * dt)
    num_re, num_im = abar_re - 1.0, abar_im
    den = lr * lr + li * li
    coef_re = (num_re * lr + num_im * li) / den
    coef_im = (num_im * lr - num_re * li) / den
    br, bi = b_re.astype(f32), b_im.astype(f32)
    bbar_re = coef_re[..., None] * br - coef_im[..., None] * bi
    bbar_im = coef_re[..., None] * bi + coef_im[..., None] * br
    bu_re = jnp.einsum('blgp,gnp->blgn', u, bbar_re)
    bu_im = jnp.einsum('blgp,gnp->blgn', u, bbar_im)
    a_re = jnp.broadcast_to(abar_re, bu_re.shape)
    a_im = jnp.broadcast_to(abar_im, bu_im.shape)

    def combine(e1, e2):
        ar1, ai1, br1, bi1 = e1
        ar2, ai2, br2, bi2 = e2
        return (ar2 * ar1 - ai2 * ai1,
                ar2 * ai1 + ai2 * ar1,
                ar2 * br1 - ai2 * bi1 + br2,
                ar2 * bi1 + ai2 * br1 + bi2)

    _, _, xr, xi = lax.associative_scan(combine, (a_re, a_im, bu_re, bu_im), axis=1)
    y = (jnp.einsum('gpn,blgn->blgp', c_re.astype(f32), xr)
         - jnp.einsum('gpn,blgn->blgp', c_im.astype(f32), xi))
    return y + d_skip.astype(f32) * u


def _mixer(u, lb, w_in, hg_norm, hg_w_proj, s5_lam_re, s5_lam_im, s5_log_step,
           s5_b_re, s5_b_im, s5_c_re, s5_c_im, s5_d, s5_w_glu_a, s5_w_glu_b, w_out):
    f32 = jnp.float32
    B, L, _ = u.shape
    proj = u @ w_in
    q, f_logit, i_in, g_out, s5_u, gate_hg, gate_s5 = jnp.split(proj, _split_points(), axis=-1)

    qh = (jax.nn.silu(q.astype(f32)) * HG_DK ** -0.5).reshape(B, L, HG_HEADS, HG_DK)
    f = lb + (1.0 - lb) * jax.nn.sigmoid(f_logit.astype(f32))
    logf = jnp.log(f).reshape(B, L, HG_HEADS, HG_DK)
    kh = (1.0 - f).reshape(B, L, HG_HEADS, HG_DK)
    vh = i_in.astype(f32).reshape(B, L, HG_HEADS, HG_DV)
    pad = HG_CHUNK - N_META
    padw = ((0, 0), (pad, 0), (0, 0), (0, 0))
    o = _hgrn2_chunkwise(jnp.pad(qh, padw), jnp.pad(logf, padw),
                         jnp.pad(kh, padw), jnp.pad(vh, padw))[:, pad:]
    o = o * lax.rsqrt(jnp.mean(o * o, axis=-1, keepdims=True) + EPS)
    o = o.reshape(B, L, HG_WIDTH) * hg_norm.astype(f32) * jax.nn.silu(g_out.astype(f32))
    y_hg = o.astype(u.dtype) @ hg_w_proj

    us = s5_u.astype(f32).reshape(B, L, S5_GROUPS, S5_GROUP)
    ys = _s5_scan(us, s5_lam_re, s5_lam_im, s5_log_step, s5_b_re, s5_b_im,
                  s5_c_re, s5_c_im, s5_d)
    z = jax.nn.gelu(ys.reshape(B, L, S5_WIDTH)).astype(u.dtype)
    y_s5 = (z @ s5_w_glu_a) * jax.nn.sigmoid(z @ s5_w_glu_b)

    merged = jax.nn.sigmoid(gate_hg) * y_hg + jax.nn.sigmoid(gate_s5) * y_s5
    return merged @ w_out


def setup_inputs(seed: int = 0) -> dict:
    key = jax.random.key(seed)
    ks = jax.random.split(key, 32)
    f32 = jnp.float32

    def nrm(k, shape, scale):
        return jax.random.normal(k, shape, f32) * scale

    def gain(k, shape):
        return 1.0 + 0.02 * jax.random.normal(k, shape, f32)

    Ld = DEPTH
    n_idx = jnp.arange(S5_STATE, dtype=f32)
    return {
        "x": nrm(ks[0], (BATCH, SEQ, D_MODEL), 1.0),
        "meta_tokens": nrm(ks[1], (N_META, D_MODEL), 1.0),
        "norm_ffn1": gain(ks[2], (Ld, D_MODEL)),
        "ffn1_w_gate": nrm(ks[3], (Ld, D_MODEL, D_FF), D_MODEL ** -0.5),
        "ffn1_w_up": nrm(ks[4], (Ld, D_MODEL, D_FF), D_MODEL ** -0.5),
        "ffn1_w_down": nrm(ks[5], (Ld, D_FF, D_MODEL), D_FF ** -0.5),
        "norm_mix": gain(ks[6], (Ld, D_MODEL)),
        "w_in": nrm(ks[7], (Ld, D_MODEL, IN_COLS), D_MODEL ** -0.5),
        "hg_lower_bounds": nrm(ks[8], (Ld + 1, HG_K), 0.1),
        "hg_norm": gain(ks[9], (Ld, HG_WIDTH)),
        "hg_w_proj": nrm(ks[10], (Ld, HG_WIDTH, D_MODEL), HG_WIDTH ** -0.5),
        "s5_lam_re": -0.5 + nrm(ks[11], (Ld, S5_GROUPS, S5_STATE), 0.01),
        "s5_lam_im": math.pi * n_idx + nrm(ks[12], (Ld, S5_GROUPS, S5_STATE), 0.01),
        "s5_log_step": jax.random.uniform(ks[13], (Ld, S5_GROUPS), f32,
                                          math.log(DT_MIN), math.log(DT_MAX)),
        "s5_b_re": nrm(ks[14], (Ld, S5_GROUPS, S5_STATE, S5_GROUP), (2 * S5_GROUP) ** -0.5),
        "s5_b_im": nrm(ks[15], (Ld, S5_GROUPS, S5_STATE, S5_GROUP), (2 * S5_GROUP) ** -0.5),
        "s5_c_re": nrm(ks[16], (Ld, S5_GROUPS, S5_GROUP, S5_STATE), (2 * S5_STATE) ** -0.5),
        "s5_c_im": nrm(ks[17], (Ld, S5_GROUPS, S5_GROUP, S5_STATE), (2 * S5_STATE) ** -0.5),
        "s5_d": nrm(ks[18], (Ld, S5_GROUPS, S5_GROUP), 1.0),
        "s5_w_glu_a": nrm(ks[19], (Ld, S5_WIDTH, D_MODEL), S5_WIDTH ** -0.5),
        "s5_w_glu_b": nrm(ks[20], (Ld, S5_WIDTH, D_MODEL), S5_WIDTH ** -0.5),
        "w_out": nrm(ks[21], (Ld, D_MODEL, D_MODEL), D_MODEL ** -0.5),
        "norm_ffn2": gain(ks[22], (Ld, D_MODEL)),
        "ffn2_w_gate": nrm(ks[23], (Ld, D_MODEL, D_FF), D_MODEL ** -0.5),
        "ffn2_w_up": nrm(ks[24], (Ld, D_MODEL, D_FF), D_MODEL ** -0.5),
        "ffn2_w_down": nrm(ks[25], (Ld, D_FF, D_MODEL), D_FF ** -0.5),
        "norm_final": gain(ks[26], (D_MODEL,)),
    }


def reference(x, meta_tokens, norm_ffn1, ffn1_w_gate, ffn1_w_up, ffn1_w_down, norm_mix,
              w_in, hg_lower_bounds, hg_norm, hg_w_proj, s5_lam_re, s5_lam_im, s5_log_step,
              s5_b_re, s5_b_im, s5_c_re, s5_c_im, s5_d, s5_w_glu_a, s5_w_glu_b, w_out,
              norm_ffn2, ffn2_w_gate, ffn2_w_up, ffn2_w_down, norm_final):
    B = x.shape[0]
    meta = jnp.broadcast_to(meta_tokens.astype(x.dtype)[None], (B, N_META, D_MODEL))
    h = jnp.concatenate([meta, x], axis=1)
    lbs = jnp.cumsum(jax.nn.softmax(hg_lower_bounds.astype(jnp.float32), axis=0), axis=0)
    for l in range(DEPTH):
        h = h + 0.5 * _swiglu(_rms_norm(h, norm_ffn1[l]), ffn1_w_gate[l], ffn1_w_up[l], ffn1_w_down[l])
        mix = _mixer(_rms_norm(h, norm_mix[l]), lbs[l], w_in[l], hg_norm[l], hg_w_proj[l],
                     s5_lam_re[l], s5_lam_im[l], s5_log_step[l], s5_b_re[l], s5_b_im[l],
                     s5_c_re[l], s5_c_im[l], s5_d[l], s5_w_glu_a[l], s5_w_glu_b[l], w_out[l])
        h = h + mix.astype(h.dtype)
        h = h + 0.5 * _swiglu(_rms_norm(h, norm_ffn2[l]), ffn2_w_gate[l], ffn2_w_up[l], ffn2_w_down[l])
    return _rms_norm(h, norm_final)[:, N_META:]
```

```cpp
#include <hip/hip_runtime.h>
#include <hip/hip_cooperative_groups.h>
#include <cstdio>
namespace cg = cooperative_groups;

#ifndef MK_MULTI
#define MK_MULTI 0
#endif

namespace pg8 {
#define PG8_LAS __attribute__((address_space(3)))
typedef unsigned short bf16_t;
typedef short bf16x8 __attribute__((ext_vector_type(8)));
typedef float f32x4 __attribute__((ext_vector_type(4)));
typedef unsigned u32x4 __attribute__((ext_vector_type(4)));
typedef unsigned u32x2 __attribute__((ext_vector_type(2)));
constexpr int BM = 256, BK = 64, HALF = 128, HTB = HALF * BK * 2  , STAGE_BYTES = 8 * HTB, NXCD = 8, WGM = 8;

__host__ __device__ __forceinline__ int lds_byte(int r, int c) { const int st = (r >> 4) * 2 + (c >> 5), rr = r & 15, cc = c & 31, ob = rr * 64 + cc * 2; return st * 1024 + (ob ^ (((ob >> 9) & 1) << 5)); }
__host__ __device__ __forceinline__ void stage_rc(int b, int& R, int& C) { const int st = b / 1024, sb = b % 1024, swz = sb ^ (((sb >> 9) & 1) << 5); R = (st >> 1) * 16 + swz / 64; C = (st & 1) * 32 + (swz % 64) / 2; }
__host__ __device__ __forceinline__ int perm32(int rho) { const int n = rho >> 4, i = rho & 15; return 8 * (i >> 2) + 4 * n + (i & 3); }

struct Unit { int pm, pn; };
struct Gemm { const bf16_t* A; const bf16_t* Bt; int M, N, K; };

struct StaticOrder {
    int nM, nN, nwg, G, c;
    __host__ __device__ void init(int M, int N, int G_, int c_) { nM = M / BM; nN = N / BM; nwg = nM * nN; G = G_; c = c_; }
    __host__ __device__ bool next(int i, Unit& u) const {
        const long L = (long)i * G + c; if (L >= nwg) return false;
        int wgid = (int)L; { const int q = nwg / NXCD, r = nwg % NXCD, xcd = wgid % NXCD, off = wgid / NXCD; wgid = (xcd < r ? xcd * (q + 1) : r * (q + 1) + (xcd - r) * q) + off; }
        const int nig = WGM * nN, gid = wgid / nig, fm = gid * WGM, gsz = (nM - fm) < WGM ? (nM - fm) : WGM;
        u.pm = fm + ((wgid % nig) % gsz); u.pn = (wgid % nig) / gsz; return true;
    }
    __device__ __forceinline__ void a_ready(const Unit&) const {}
    __device__ __forceinline__ void done(const Unit&) const {}
};
typedef float f32x2v __attribute__((ext_vector_type(2)));
typedef __bf16 bf16x2v __attribute__((ext_vector_type(2)));
__device__ __forceinline__ unsigned cvt_pk_bf16(float lo, float hi) { const f32x2v v = {lo, hi}; const bf16x2v b = __builtin_convertvector(v, bf16x2v); return __builtin_bit_cast(unsigned, b); }

template <class Epi, class Sched>
__device__ __forceinline__ void gemm_phase(PG8_LAS unsigned char* lds, const Gemm g, const Sched& S, const Epi& E) {
    const int tid = threadIdx.x, wid = __builtin_amdgcn_readfirstlane(tid >> 6), lane = tid & 63, wr = wid >> 2, wc = wid & 3, fr = lane & 15, fq = lane >> 4;
    const int K = g.K, nt = K / BK;
    unsigned voffA[2], voffB[2];
#pragma unroll
    for (int i = 0; i < 2; ++i) { int R, C; stage_rc(tid * 16 + i * 8192, R, C); const int Rb = Epi::PERM ? ((R & ~31) + perm32(R & 31)) : R;
        voffA[i] = (unsigned)(R * K + C) * 2u; voffB[i] = (unsigned)(Rb * K + C) * 2u; }
    const size_t kstep = (size_t)(BK * 2);
    const size_t hstep = (size_t)HALF * K * 2;
    const size_t tstep = 2 * hstep;
    const unsigned ldsw = (unsigned)wid * 1024u;
    const int aoff = lds_byte(wr * 64 + fr, fq * 8), boff = lds_byte(wc * 32 + fr, fq * 8);
#define PG8_SA(b, h) (((b) * 2 + (h)) * HTB)
#define PG8_SB(b, h) ((4 + (b) * 2 + (h)) * HTB)
#define PG8_STAGE(bufoff, gbase, voff) do { _Pragma("unroll") for (int _i = 0; _i < 2; ++_i) \
        __builtin_amdgcn_global_load_lds((const unsigned*)((const char*)(gbase) + (voff)[_i]), (PG8_LAS unsigned*)(lds + (bufoff) + ldsw + _i * 8192), 16, 0, 0); } while (0)
#define PG8_LDA(dst, b, h) do { _Pragma("unroll") for (int m = 0; m < 4; ++m) _Pragma("unroll") for (int k = 0; k < 2; ++k) dst[m][k] = *(const PG8_LAS bf16x8*)(lds + PG8_SA(b, h) + aoff + m * 2048 + k * 1024); } while (0)
#define PG8_LDB(dst, b, h) do { _Pragma("unroll") for (int n = 0; n < 2; ++n) _Pragma("unroll") for (int k = 0; k < 2; ++k) dst[n][k] = *(const PG8_LAS bf16x8*)(lds + PG8_SB(b, h) + boff + n * 2048 + k * 1024); } while (0)
#define PG8_MMA(ai, bj, At, Bt) do { __builtin_amdgcn_s_setprio(1); _Pragma("unroll") for (int m = 0; m < 4; ++m) _Pragma("unroll") for (int n = 0; n < 2; ++n) _Pragma("unroll") for (int k = 0; k < 2; ++k) \
        acc[ai][bj][m][n] = __builtin_amdgcn_mfma_f32_16x16x32_bf16(Bt[n][k], At[m][k], acc[ai][bj][m][n], 0, 0, 0); __builtin_amdgcn_s_setprio(0); } while (0)
#define PG8_WAIT_V(n) asm volatile("s_waitcnt vmcnt(" #n ")" ::: "memory")
#define PG8_WAIT_L(n) asm volatile("s_waitcnt lgkmcnt(" #n ")" ::: "memory")
#define PG8_BAR __builtin_amdgcn_s_barrier()
#define PG8_SCHED __builtin_amdgcn_sched_barrier(0)
    Unit cur, nxt; int ui = 0;
    if (!S.next(0, cur)) return;
    f32x4 acc[2][2][4][2];
#pragma unroll
    for (int a = 0; a < 2; ++a)
#pragma unroll
        for (int b = 0; b < 2; ++b)
#pragma unroll
            for (int m = 0; m < 4; ++m)
#pragma unroll
                for (int n = 0; n < 2; ++n) acc[a][b][m][n] = (f32x4){0.f, 0.f, 0.f, 0.f};
    bf16x8 At[4][2], B0[2][2], B1[2][2];
    const char* cA = (const char*)g.A + (size_t)cur.pm * tstep; const char* cB = (const char*)g.Bt + (size_t)cur.pn * tstep;
    S.a_ready(cur);
    PG8_STAGE(PG8_SB(0, 0), cB, voffB); PG8_STAGE(PG8_SA(0, 0), cA, voffA); PG8_STAGE(PG8_SB(0, 1), cB + hstep, voffB); PG8_STAGE(PG8_SA(0, 1), cA + hstep, voffA);
    if (wr == 1) PG8_BAR;
    PG8_WAIT_V(4); PG8_BAR;
    PG8_STAGE(PG8_SB(1, 0), cB + kstep, voffB); PG8_STAGE(PG8_SA(1, 0), cA + kstep, voffA); PG8_STAGE(PG8_SB(1, 1), cB + hstep + kstep, voffB);
    PG8_WAIT_V(6); PG8_BAR;
    for (;;) {
        const bool has_next = S.next(ui + 1, nxt);
        const char* nA = has_next ? (const char*)g.A + (size_t)nxt.pm * tstep : cA; const char* nB = has_next ? (const char*)g.Bt + (size_t)nxt.pn * tstep : cB;
        for (int t = 0; t < nt; t += 2) {
            const bool last = (t == nt - 2);
            const char* a1 = cA + (size_t)(t + 1) * kstep;
            const char* a2 = last ? nA : cA + (size_t)(t + 2) * kstep; const char* b2 = last ? nB : cB + (size_t)(t + 2) * kstep;
            const char* a3 = a2 + kstep; const char* b3 = b2 + kstep;
            if (last && has_next) S.a_ready(nxt);
            PG8_LDB(B0, 0, 0); PG8_SCHED; PG8_LDA(At, 0, 0); PG8_STAGE(PG8_SA(1, 1), a1 + hstep, voffA);
            PG8_WAIT_L(8); PG8_BAR; PG8_WAIT_L(0); PG8_MMA(0, 0, At, B0); PG8_BAR; PG8_SCHED;
            PG8_LDB(B1, 0, 1); PG8_STAGE(PG8_SB(0, 0), b2, voffB);
            PG8_BAR; PG8_WAIT_L(0); PG8_MMA(0, 1, At, B1); PG8_BAR;
            PG8_LDA(At, 0, 1); PG8_STAGE(PG8_SA(0, 0), a2, voffA);
            PG8_BAR; PG8_WAIT_L(0); PG8_MMA(1, 0, At, B0); PG8_BAR; PG8_SCHED;
            PG8_STAGE(PG8_SB(0, 1), b2 + hstep, voffB);
            PG8_WAIT_V(6); PG8_BAR; PG8_MMA(1, 1, At, B1); PG8_BAR;
            PG8_LDB(B0, 1, 0); PG8_SCHED; PG8_LDA(At, 1, 0); PG8_STAGE(PG8_SA(0, 1), a2 + hstep, voffA);
            PG8_WAIT_L(8); PG8_BAR; PG8_WAIT_L(0); PG8_MMA(0, 0, At, B0); PG8_BAR; PG8_SCHED;
            PG8_LDB(B1, 1, 1); PG8_STAGE(PG8_SB(1, 0), b3, voffB);
            PG8_BAR; PG8_WAIT_L(0); PG8_MMA(0, 1, At, B1); PG8_BAR;
            PG8_LDA(At, 1, 1); PG8_STAGE(PG8_SA(1, 0), a3, voffA);
            PG8_BAR; PG8_WAIT_L(0); PG8_MMA(1, 0, At, B0); PG8_BAR; PG8_SCHED;
            PG8_STAGE(PG8_SB(1, 1), b3 + hstep, voffB);
            PG8_WAIT_V(6); PG8_BAR; PG8_MMA(1, 1, At, B1); PG8_BAR;
        }
        if constexpr (!Epi::AFTER_DRAIN) { E(acc, cur, wr, wc, fr, fq); S.done(cur); }
        if (!has_next) break;
#pragma unroll
        for (int a = 0; a < 2; ++a)
#pragma unroll
            for (int b = 0; b < 2; ++b)
#pragma unroll
                for (int m = 0; m < 4; ++m)
#pragma unroll
                    for (int n = 0; n < 2; ++n) acc[a][b][m][n] = (f32x4){0.f, 0.f, 0.f, 0.f};
        cur = nxt; cA = nA; cB = nB; ++ui;
    }
    PG8_WAIT_V(0);
    if (wr == 0) PG8_BAR;
    PG8_BAR;
    if constexpr (Epi::AFTER_DRAIN) { E.fused(acc, cur, wr, wc, fr, fq, lds, wid, lane); S.done(cur); }
#undef PG8_SA
#undef PG8_SB
#undef PG8_STAGE
#undef PG8_LDA
#undef PG8_LDB
#undef PG8_MMA
#undef PG8_WAIT_V
#undef PG8_WAIT_L
#undef PG8_BAR
#undef PG8_SCHED
}
}

using pg8::bf16_t; using pg8::bf16x8; using pg8::f32x4; using pg8::u32x4; using pg8::u32x2; using pg8::cvt_pk_bf16;
#define LAS __attribute__((address_space(3)))
constexpr int D = 2048, FF = 5632, MR = 8192, NMETA = 16, MP = 8448;
constexpr int HK = 1536, NH = 12, S5W = 512, NS = 64;
constexpr int NREC = 6656, NGATE = 4096, INCOLS = 10752, NCH = 129;
constexpr float EPS = 1e-6f;
constexpr int LDS_BYTES = 131072;

constexpr size_t WS_WGU  = 0;
constexpr size_t WS_WD   = WS_WGU  + (size_t)2 * FF * D * 2;
constexpr size_t WS_WIN  = WS_WD   + (size_t)D * FF * 2;
constexpr size_t WS_WHG  = WS_WIN  + (size_t)INCOLS * D * 2;
constexpr size_t WS_WGLU = WS_WHG  + (size_t)D * HK * 2;
constexpr size_t WS_WOUT = WS_WGLU + (size_t)2 * D * S5W * 2;
constexpr size_t WS_HRES = WS_WOUT + (size_t)D * D * 2;
constexpr size_t WS_ABUF = WS_HRES + (size_t)MP * D * 4;
constexpr size_t WS_Q    = WS_ABUF + (size_t)MP * D * 2;
constexpr size_t WS_K    = WS_Q    + (size_t)MP * HK * 2;
constexpr size_t WS_LOGF = WS_K    + (size_t)MP * HK * 2;
constexpr size_t WS_V    = WS_LOGF + (size_t)MP * HK * 4;
constexpr size_t WS_GS   = WS_V    + (size_t)MP * HK * 2;
constexpr size_t WS_S5U  = WS_GS   + (size_t)MP * HK * 2;
constexpr size_t WS_Z    = WS_S5U  + (size_t)MP * S5W * 4;
constexpr size_t WS_PARTA= WS_Z    + (size_t)MR * S5W * 2;
constexpr size_t WS_PARTB= WS_PARTA+ (size_t)MP * 32 * 4;
constexpr size_t WS_DEC  = WS_PARTB+ (size_t)MP * 32 * 4;
constexpr size_t WS_S5E  = WS_DEC  + (size_t)128 * NH * 128 * 4;
constexpr size_t WS_END  = WS_S5E  + (size_t)NCH * 2048 * 8;
constexpr size_t WS_H     = WS_Q;
constexpr size_t WS_GATES = WS_Q;
static_assert((size_t)MP * FF * 2 <= WS_V - WS_Q, "H alias");
constexpr size_t DO_YS = 0, DO_MERGED = (size_t)MR * D * 2;

struct Args { const float* in[27]; float* out; unsigned char* ws; int lo, hi; };

__device__ __forceinline__ float bf_lo(unsigned w) { return __uint_as_float(w << 16); }
__device__ __forceinline__ float bf_hi(unsigned w) { return __uint_as_float(w & 0xffff0000u); }
__device__ __forceinline__ float bf2f(bf16_t b) { return __uint_as_float(((unsigned)b) << 16); }
__device__ __forceinline__ float fsigmoid(float x) { return __builtin_amdgcn_rcpf(1.0f + __expf(-x)); }
__device__ __forceinline__ float fsilu(float x) { return x * fsigmoid(x); }
#define LDS_WAIT() asm volatile("s_waitcnt lgkmcnt(0)" ::: "memory")

__device__ __forceinline__ void row_rstd(const float* part, int row0, int fq, float (&rs)[2][4]) {
#pragma unroll
    for (int ai = 0; ai < 2; ++ai)
#pragma unroll
        for (int m = 0; m < 4; ++m) {
            const f32x4* p = (const f32x4*)(part + (size_t)(row0 + ai * 128 + m * 16) * 32 + fq * 8);
            const f32x4 a = p[0], b = p[1];
            float s = ((a.x + a.y) + (a.z + a.w)) + ((b.x + b.y) + (b.z + b.w));
            s += __shfl_xor(s, 16); s += __shfl_xor(s, 32);
            rs[ai][m] = rsqrtf(s * (1.0f / D) + EPS);
        }
}
struct EpiSwiglu {
    static constexpr bool PERM = true, AFTER_DRAIN = false;
    bf16_t* H; const float* part;
    __device__ __forceinline__ void operator()(const f32x4 (&acc)[2][2][4][2], const pg8::Unit& u, int wr, int wc, int fr, int fq) const {
        const int row0 = u.pm * 256 + wr * 64 + fr, col0 = u.pn * 128 + wc * 32 + 8 * fq;
        float rs[2][4]; row_rstd(part, row0, fq, rs);
#pragma unroll
        for (int ai = 0; ai < 2; ++ai)
#pragma unroll
            for (int m = 0; m < 4; ++m) {
                const float r = rs[ai][m]; float h[8];
#pragma unroll
                for (int n = 0; n < 2; ++n)
#pragma unroll
                    for (int j = 0; j < 4; ++j) h[n * 4 + j] = fsilu(acc[ai][0][m][n][j] * r) * (acc[ai][1][m][n][j] * r);
                u32x4 w; w.x = cvt_pk_bf16(h[0], h[1]); w.y = cvt_pk_bf16(h[2], h[3]); w.z = cvt_pk_bf16(h[4], h[5]); w.w = cvt_pk_bf16(h[6], h[7]);
                *(u32x4*)(H + (size_t)(row0 + ai * 128 + m * 16) * FF + col0) = w;
            }
    }
};
struct EpiRes {
    static constexpr bool PERM = false, AFTER_DRAIN = false;
    const float* res; const float* x; const float* meta; float* out; bf16_t* outb; float* part; float alpha; int mode;
    __device__ __forceinline__ void operator()(const f32x4 (&acc)[2][2][4][2], const pg8::Unit& u, int wr, int wc, int fr, int fq) const {
        const int row0 = u.pm * 256 + wr * 64 + fr, col0 = u.pn * 256 + wc * 32 + 4 * fq;
#pragma unroll
        for (int ai = 0; ai < 2; ++ai)
#pragma unroll
            for (int m = 0; m < 4; ++m) {
                const int row = row0 + ai * 128 + m * 16;
                const float* rp = mode ? res + (size_t)row * D : (row < MR ? x + (size_t)row * D : (row < MR + NMETA ? meta + (size_t)(row - MR) * D : nullptr));
                float ss = 0.f;
#pragma unroll
                for (int bj = 0; bj < 2; ++bj)
#pragma unroll
                    for (int n = 0; n < 2; ++n) {
                        const int c = col0 + bj * 128 + n * 16;
                        f32x4 r = rp ? *(const f32x4*)(rp + c) : (f32x4){0.f, 0.f, 0.f, 0.f};
                        const f32x4 o = r + acc[ai][bj][m][n] * alpha;
                        *(f32x4*)(out + (size_t)row * D + c) = o;
                        ss += (o.x * o.x + o.y * o.y) + (o.z * o.z + o.w * o.w);
                        if (outb) { u32x2 w; w.x = cvt_pk_bf16(o.x, o.y); w.y = cvt_pk_bf16(o.z, o.w); *(u32x2*)(outb + (size_t)row * D + c) = w; }
                    }
                ss += __shfl_xor(ss, 16); ss += __shfl_xor(ss, 32);
                if (fq == 0) part[(size_t)row * 32 + u.pn * 4 + wc] = ss;
            }
    }
};
struct EpiRec {
    static constexpr bool PERM = true, AFTER_DRAIN = false;
    bf16_t *Q, *Kb, *V, *GS; float *LOGF, *S5U; const float* part; const float* lbp;
    __device__ __forceinline__ void operator()(const f32x4 (&acc)[2][2][4][2], const pg8::Unit& u, int wr, int wc, int fr, int fq) const {
        const int row0 = u.pm * 256 + wr * 64 + fr, colt = u.pn * 256 + wc * 32 + 8 * fq;
        float rs[2][4]; row_rstd(part, row0, fq, rs);
        const int seg = u.pn < 6 ? 0 : (u.pn < 12 ? 1 : (u.pn < 18 ? 2 : (u.pn < 24 ? 3 : 4)));
#pragma unroll
        for (int bj = 0; bj < 2; ++bj) {
            const int c = colt + bj * 128;
            float lb[8];
            if (seg == 1) {
#pragma unroll
                for (int e = 0; e < 8; ++e) { const float a0 = lbp[c - HK + e], a1 = lbp[HK + c - HK + e]; lb[e] = 1.0f / (1.0f + expf(a1 - a0)); }
            }
#pragma unroll
            for (int ai = 0; ai < 2; ++ai)
#pragma unroll
                for (int m = 0; m < 4; ++m) {
                    const size_t row = (size_t)(row0 + ai * 128 + m * 16); const float r = rs[ai][m];
                    float v[8];
#pragma unroll
                    for (int n = 0; n < 2; ++n)
#pragma unroll
                        for (int j = 0; j < 4; ++j) v[n * 4 + j] = acc[ai][bj][m][n][j] * r;
                    if (seg == 0) {
#pragma unroll
                        for (int e = 0; e < 8; ++e) v[e] = fsilu(v[e]) * 0.08838834764831845f;
                        u32x4 w; w.x = cvt_pk_bf16(v[0], v[1]); w.y = cvt_pk_bf16(v[2], v[3]); w.z = cvt_pk_bf16(v[4], v[5]); w.w = cvt_pk_bf16(v[6], v[7]);
                        *(u32x4*)(Q + row * HK + c) = w;
                    } else if (seg == 1) {
                        float kk[8], lf[8];
#pragma unroll
                        for (int e = 0; e < 8; ++e) { const float sg = 1.0f / (1.0f + __expf(-v[e])); const float f = lb[e] + (1.0f - lb[e]) * sg; kk[e] = 1.0f - f; lf[e] = __logf(f); }
                        u32x4 w; w.x = cvt_pk_bf16(kk[0], kk[1]); w.y = cvt_pk_bf16(kk[2], kk[3]); w.z = cvt_pk_bf16(kk[4], kk[5]); w.w = cvt_pk_bf16(kk[6], kk[7]);
                        *(u32x4*)(Kb + row * HK + (c - HK)) = w;
                        *(f32x4*)(LOGF + row * HK + (c - HK)) = (f32x4){lf[0], lf[1], lf[2], lf[3]};
                        *(f32x4*)(LOGF + row * HK + (c - HK) + 4) = (f32x4){lf[4], lf[5], lf[6], lf[7]};
                    } else if (seg == 2) {
                        u32x4 w; w.x = cvt_pk_bf16(v[0], v[1]); w.y = cvt_pk_bf16(v[2], v[3]); w.z = cvt_pk_bf16(v[4], v[5]); w.w = cvt_pk_bf16(v[6], v[7]);
                        *(u32x4*)(V + row * HK + (c - 2 * HK)) = w;
                    } else if (seg == 3) {
#pragma unroll
                        for (int e = 0; e < 8; ++e) v[e] = fsilu(v[e]);
                        u32x4 w; w.x = cvt_pk_bf16(v[0], v[1]); w.y = cvt_pk_bf16(v[2], v[3]); w.z = cvt_pk_bf16(v[4], v[5]); w.w = cvt_pk_bf16(v[6], v[7]);
                        *(u32x4*)(GS + row * HK + (c - 3 * HK)) = w;
                    } else {
                        *(f32x4*)(S5U + row * S5W + (c - 4 * HK)) = (f32x4){v[0], v[1], v[2], v[3]};
                        *(f32x4*)(S5U + row * S5W + (c - 4 * HK) + 4) = (f32x4){v[4], v[5], v[6], v[7]};
                    }
                }
        }
    }
};
struct EpiGates {
    static constexpr bool PERM = true, AFTER_DRAIN = false;
    bf16_t* G; const float* part;
    __device__ __forceinline__ void operator()(const f32x4 (&acc)[2][2][4][2], const pg8::Unit& u, int wr, int wc, int fr, int fq) const {
        const int row0 = u.pm * 256 + wr * 64 + fr, colt = u.pn * 256 + wc * 32 + 8 * fq;
        float rs[2][4]; row_rstd(part, row0, fq, rs);
#pragma unroll
        for (int ai = 0; ai < 2; ++ai)
#pragma unroll
            for (int m = 0; m < 4; ++m) {
                const float r = rs[ai][m];
#pragma unroll
                for (int bj = 0; bj < 2; ++bj) {
                    float v[8];
#pragma unroll
                    for (int n = 0; n < 2; ++n)
#pragma unroll
                        for (int j = 0; j < 4; ++j) v[n * 4 + j] = fsigmoid(acc[ai][bj][m][n][j] * r);
                    u32x4 w; w.x = cvt_pk_bf16(v[0], v[1]); w.y = cvt_pk_bf16(v[2], v[3]); w.z = cvt_pk_bf16(v[4], v[5]); w.w = cvt_pk_bf16(v[6], v[7]);
                    *(u32x4*)(G + (size_t)(row0 + ai * 128 + m * 16) * NGATE + colt + bj * 128) = w;
                }
            }
    }
};
struct EpiGlu {
    static constexpr bool PERM = true, AFTER_DRAIN = false;
    const bf16_t* G; bf16_t* YS;
    __device__ __forceinline__ void operator()(const f32x4 (&acc)[2][2][4][2], const pg8::Unit& u, int wr, int wc, int fr, int fq) const {
        const int row0 = u.pm * 256 + wr * 64 + fr, col0 = u.pn * 128 + wc * 32 + 8 * fq;
#pragma unroll
        for (int ai = 0; ai < 2; ++ai)
#pragma unroll
            for (int m = 0; m < 4; ++m) {
                const size_t row = (size_t)(row0 + ai * 128 + m * 16);
                const u32x4 gw = *(const u32x4*)(G + row * NGATE + D + col0);
                const float g[8] = {bf_lo(gw.x), bf_hi(gw.x), bf_lo(gw.y), bf_hi(gw.y), bf_lo(gw.z), bf_hi(gw.z), bf_lo(gw.w), bf_hi(gw.w)};
                float y[8];
#pragma unroll
                for (int n = 0; n < 2; ++n)
#pragma unroll
                    for (int j = 0; j < 4; ++j) y[n * 4 + j] = g[n * 4 + j] * acc[ai][0][m][n][j] * fsigmoid(acc[ai][1][m][n][j]);
                u32x4 w; w.x = cvt_pk_bf16(y[0], y[1]); w.y = cvt_pk_bf16(y[2], y[3]); w.z = cvt_pk_bf16(y[4], y[5]); w.w = cvt_pk_bf16(y[6], y[7]);
                *(u32x4*)(YS + row * D + col0) = w;
            }
    }
};
struct EpiMerge {
    static constexpr bool PERM = true, AFTER_DRAIN = false;
    const bf16_t* G; const bf16_t* YS; bf16_t* MG;
    __device__ __forceinline__ void operator()(const f32x4 (&acc)[2][2][4][2], const pg8::Unit& u, int wr, int wc, int fr, int fq) const {
        const int row0 = u.pm * 256 + wr * 64 + fr, colt = u.pn * 256 + wc * 32 + 8 * fq;
#pragma unroll
        for (int ai = 0; ai < 2; ++ai)
#pragma unroll
            for (int m = 0; m < 4; ++m) {
                const size_t row = (size_t)(row0 + ai * 128 + m * 16);
#pragma unroll
                for (int bj = 0; bj < 2; ++bj) {
                    const int c = colt + bj * 128;
                    const u32x4 gw = *(const u32x4*)(G + row * NGATE + c), yw = *(const u32x4*)(YS + row * D + c);
                    const float g[8] = {bf_lo(gw.x), bf_hi(gw.x), bf_lo(gw.y), bf_hi(gw.y), bf_lo(gw.z), bf_hi(gw.z), bf_lo(gw.w), bf_hi(gw.w)};
                    const float y[8] = {bf_lo(yw.x), bf_hi(yw.x), bf_lo(yw.y), bf_hi(yw.y), bf_lo(yw.z), bf_hi(yw.z), bf_lo(yw.w), bf_hi(yw.w)};
                    float o[8];
#pragma unroll
                    for (int n = 0; n < 2; ++n)
#pragma unroll
                        for (int j = 0; j < 4; ++j) o[n * 4 + j] = g[n * 4 + j] * acc[ai][bj][m][n][j] + y[n * 4 + j];
                    u32x4 w; w.x = cvt_pk_bf16(o[0], o[1]); w.y = cvt_pk_bf16(o[2], o[3]); w.z = cvt_pk_bf16(o[4], o[5]); w.w = cvt_pk_bf16(o[6], o[7]);
                    *(u32x4*)(MG + row * D + c) = w;
                }
            }
    }
};

__device__ __forceinline__ float wave_sum(float v) {
#pragma unroll
    for (int o = 1; o < 64; o <<= 1) v += __shfl_xor(v, o);
    return v;
}
__device__ __forceinline__ void tr_item(const float* W, int K, int N, bf16_t* WT, const float* gain, int ilv, LAS float* scr, int item, int lane) {
    const int nblk = N / 32, kb = item / nblk, nb = item - kb * nblk, k0 = 64 * kb, n0 = 32 * nb;
#pragma unroll 8
    for (int i = 0; i < 32; ++i) { const int kk = 2 * i + (lane >> 5); float w = W[(size_t)(k0 + kk) * N + n0 + (lane & 31)]; if (gain) w *= gain[k0 + kk]; scr[kk * 33 + (lane & 31)] = w; }
    LDS_WAIT();
    const int c = lane & 7;
#pragma unroll
    for (int j = 0; j < 4; ++j) { const int n = (lane >> 3) + 8 * j; const LAS float* s = scr + (8 * c) * 33 + n;
        u32x4 o; o.x = cvt_pk_bf16(s[0 * 33], s[1 * 33]); o.y = cvt_pk_bf16(s[2 * 33], s[3 * 33]); o.z = cvt_pk_bf16(s[4 * 33], s[5 * 33]); o.w = cvt_pk_bf16(s[6 * 33], s[7 * 33]);
        const int nn = n0 + n; const int drow = ilv ? ((nn >> 7) * 256 + (ilv - 1) * 128 + (nn & 127)) : nn;
        *(u32x4*)(WT + (size_t)drow * K + k0 + 8 * c) = o; }
    LDS_WAIT();
}
struct TrJob { const float* W; int K, N; bf16_t* WT; const float* gain; int ilv; };
__device__ __forceinline__ void tr_run(const TrJob& j, int& it, int NGW, LAS float* scr, int lane) {
    const int n = (j.K / 64) * (j.N / 32);
    for (; it < n; it += NGW) tr_item(j.W, j.K, j.N, j.WT, j.gain, j.ilv, scr, it, lane);
    it -= n;
}

constexpr int HG_A1 = 0, HG_A2 = 17408, HG_BK = 34816, HG_ST = 52224, HG_VT = 87040, HG_P = 105472, HG_SSQ = 114688;
constexpr int HL_KT = 0, HL_VT = 18432, HL_QT = 36864;
__device__ __forceinline__ void hg_local_item(LAS unsigned char* lds, int item, float* LOGF, const bf16_t* Kb, const bf16_t* Vb, bf16_t* ST, float* DEC, int tid, int wave, int lane) {
    const int c = item / NH, h = item - c * NH;
    const int row0 = c == 0 ? MR : 64 * (c - 1), T = c == 0 ? NMETA : 64;
    const int kcol = tid & 127, tq = tid >> 7;
    float* LF = LOGF + (size_t)row0 * HK + h * 128 + kcol;
    LAS float* qt = (LAS float*)(lds + HL_QT);
    float cs[16]; float run = 0.f;
#pragma unroll
    for (int i = 0; i < 16; ++i) { const int t = tq * 16 + i; const float v = (t < T) ? LF[(size_t)t * HK] : 0.f; run += v; cs[i] = run; }
    qt[tq * 128 + kcol] = run;
    __syncthreads();
    float pre = 0.f, tot = 0.f;
#pragma unroll
    for (int q = 0; q < 4; ++q) { const float x = qt[q * 128 + kcol]; tot += x; if (q < tq) pre += x; }
#pragma unroll
    for (int i = 0; i < 16; ++i) { const int t = tq * 16 + i; cs[i] += pre; if (t < T) LF[(size_t)t * HK] = cs[i]; }
    if (c == NCH - 1) { __syncthreads(); return; }
    {
        const bf16_t* KP = Kb + (size_t)row0 * HK + h * 128 + kcol; const bf16_t* VP = Vb + (size_t)row0 * HK + h * 128 + kcol;
        float kd[16]; unsigned vv[16];
#pragma unroll
        for (int i = 0; i < 16; ++i) { const int t = tq * 16 + i; const bool ok = t < T;
            kd[i] = ok ? bf2f(KP[(size_t)t * HK]) * __expf(tot - cs[i]) : 0.f; vv[i] = ok ? (unsigned)VP[(size_t)t * HK] : 0u; }
        u32x4 a, b;
        a.x = cvt_pk_bf16(kd[0], kd[1]); a.y = cvt_pk_bf16(kd[2], kd[3]); a.z = cvt_pk_bf16(kd[4], kd[5]); a.w = cvt_pk_bf16(kd[6], kd[7]);
        b.x = cvt_pk_bf16(kd[8], kd[9]); b.y = cvt_pk_bf16(kd[10], kd[11]); b.z = cvt_pk_bf16(kd[12], kd[13]); b.w = cvt_pk_bf16(kd[14], kd[15]);
        *(LAS u32x4*)(lds + HL_KT + kcol * 144 + tq * 32) = a; *(LAS u32x4*)(lds + HL_KT + kcol * 144 + tq * 32 + 16) = b;
        a.x = vv[0] | (vv[1] << 16); a.y = vv[2] | (vv[3] << 16); a.z = vv[4] | (vv[5] << 16); a.w = vv[6] | (vv[7] << 16);
        b.x = vv[8] | (vv[9] << 16); b.y = vv[10] | (vv[11] << 16); b.z = vv[12] | (vv[13] << 16); b.w = vv[14] | (vv[15] << 16);
        *(LAS u32x4*)(lds + HL_VT + kcol * 144 + tq * 32) = a; *(LAS u32x4*)(lds + HL_VT + kcol * 144 + tq * 32 + 16) = b;
        if (tq == 0) DEC[(size_t)(c * NH + h) * 128 + kcol] = __expf(tot);
    }
    __syncthreads();
    {
        const int vt0 = (wave >> 1) * 2, kt0 = (wave & 1) * 4, lr = lane & 15, lq = lane >> 4;
        f32x4 acc[2][4];
#pragma unroll
        for (int a = 0; a < 2; ++a)
#pragma unroll
            for (int b = 0; b < 4; ++b) acc[a][b] = (f32x4){0.f, 0.f, 0.f, 0.f};
#pragma unroll
        for (int ks = 0; ks < 2; ++ks) {
            bf16x8 vf[2], kf[4];
#pragma unroll
            for (int a = 0; a < 2; ++a) vf[a] = *(const LAS bf16x8*)(lds + HL_VT + (16 * (vt0 + a) + lr) * 144 + (ks * 32 + 8 * lq) * 2);
#pragma unroll
            for (int b = 0; b < 4; ++b) kf[b] = *(const LAS bf16x8*)(lds + HL_KT + (16 * (kt0 + b) + lr) * 144 + (ks * 32 + 8 * lq) * 2);
#pragma unroll
            for (int a = 0; a < 2; ++a)
#pragma unroll
                for (int b = 0; b < 4; ++b) acc[a][b] = __builtin_amdgcn_mfma_f32_16x16x32_bf16(kf[b], vf[a], acc[a][b], 0, 0, 0);
        }
        bf16_t* dst = ST + (size_t)(c * NH + h) * 16384;
#pragma unroll
        for (int a = 0; a < 2; ++a)
#pragma unroll
            for (int b = 0; b < 4; ++b) { const int v = 16 * (vt0 + a) + lr, k = 16 * (kt0 + b) + 4 * lq;
                u32x2 w; w.x = cvt_pk_bf16(acc[a][b].x, acc[a][b].y); w.y = cvt_pk_bf16(acc[a][b].z, acc[a][b].w);
                *(u32x2*)(dst + v * 128 + k) = w; }
    }
    __syncthreads();
}
__device__ __forceinline__ void hg_out_item(LAS unsigned char* lds, int item, const float* B, const bf16_t* Q, const bf16_t* Kb, const bf16_t* Vb, const bf16_t* ST, bf16_t* GS, const float* hg_norm, int tid, int wave, int lane) {
    const int c = 1 + item / NH, h = item % NH, row0 = 64 * (c - 1);
#pragma unroll
    for (int jj = 0; jj < 2; ++jj) {
        const int p = tid + 512 * jj, t = p >> 4, k0 = 8 * (p & 15);
        const size_t off = (size_t)(row0 + t) * HK + h * 128 + k0, roff = (size_t)(row0 + 31) * HK + h * 128 + k0;
        const f32x4 b0 = *(const f32x4*)(B + off), b1 = *(const f32x4*)(B + off + 4), r0 = *(const f32x4*)(B + roff), r1 = *(const f32x4*)(B + roff + 4);
        const u32x4 qw = *(const u32x4*)(Q + off), kw = *(const u32x4*)(Kb + off);
        const float bb[8] = {b0.x, b0.y, b0.z, b0.w, b1.x, b1.y, b1.z, b1.w}, rr[8] = {r0.x, r0.y, r0.z, r0.w, r1.x, r1.y, r1.z, r1.w};
        const float qq[8] = {bf_lo(qw.x), bf_hi(qw.x), bf_lo(qw.y), bf_hi(qw.y), bf_lo(qw.z), bf_hi(qw.z), bf_lo(qw.w), bf_hi(qw.w)};
        const float kk[8] = {bf_lo(kw.x), bf_hi(kw.x), bf_lo(kw.y), bf_hi(kw.y), bf_lo(kw.z), bf_hi(kw.z), bf_lo(kw.w), bf_hi(kw.w)};
        float a1[8], a2[8], bk[8];
#pragma unroll
        for (int e = 0; e < 8; ++e) { a1[e] = qq[e] * __expf(bb[e]); a2[e] = qq[e] * __expf(bb[e] - rr[e]); bk[e] = kk[e] * __expf(rr[e] - bb[e]); }
        u32x4 w;
        w.x = cvt_pk_bf16(a1[0], a1[1]); w.y = cvt_pk_bf16(a1[2], a1[3]); w.z = cvt_pk_bf16(a1[4], a1[5]); w.w = cvt_pk_bf16(a1[6], a1[7]); *(LAS u32x4*)(lds + HG_A1 + t * 272 + k0 * 2) = w;
        w.x = cvt_pk_bf16(a2[0], a2[1]); w.y = cvt_pk_bf16(a2[2], a2[3]); w.z = cvt_pk_bf16(a2[4], a2[5]); w.w = cvt_pk_bf16(a2[6], a2[7]); *(LAS u32x4*)(lds + HG_A2 + t * 272 + k0 * 2) = w;
        w.x = cvt_pk_bf16(bk[0], bk[1]); w.y = cvt_pk_bf16(bk[2], bk[3]); w.z = cvt_pk_bf16(bk[4], bk[5]); w.w = cvt_pk_bf16(bk[6], bk[7]); *(LAS u32x4*)(lds + HG_BK + t * 272 + k0 * 2) = w;
    }
    {
        const int vcol = tid & 127, tq = tid >> 7; const bf16_t* VP = Vb + (size_t)(row0 + tq * 16) * HK + h * 128 + vcol; unsigned vv[16];
#pragma unroll
        for (int i = 0; i < 16; ++i) vv[i] = (unsigned)VP[(size_t)i * HK];
        u32x4 a, b;
        a.x = vv[0] | (vv[1] << 16); a.y = vv[2] | (vv[3] << 16); a.z = vv[4] | (vv[5] << 16); a.w = vv[6] | (vv[7] << 16);
        b.x = vv[8] | (vv[9] << 16); b.y = vv[10] | (vv[11] << 16); b.z = vv[12] | (vv[13] << 16); b.w = vv[14] | (vv[15] << 16);
        *(LAS u32x4*)(lds + HG_VT + vcol * 144 + tq * 32) = a; *(LAS u32x4*)(lds + HG_VT + vcol * 144 + tq * 32 + 16) = b;
    }
    {
        const u32x4* src = (const u32x4*)(ST + (size_t)(c * NH + h) * 16384);
#pragma unroll
        for (int jj = 0; jj < 4; ++jj) { const int idx = tid + 512 * jj; *(LAS u32x4*)(lds + HG_ST + (idx >> 4) * 272 + (idx & 15) * 16) = src[idx]; }
    }
    __syncthreads();
    const int lr = lane & 15, lq = lane >> 4;
    {
        const int tt = wave >> 1;
#pragma unroll
        for (int sh = 0; sh < 2; ++sh) {
            const int ss = 2 * (wave & 1) + sh;
            f32x4 acc = (f32x4){0.f, 0.f, 0.f, 0.f};
            if (ss <= tt) {
#pragma unroll
                for (int ks = 0; ks < 4; ++ks) {
                    const bf16x8 af = *(const LAS bf16x8*)(lds + HG_A2 + (16 * tt + lr) * 272 + (ks * 32 + 8 * lq) * 2);
                    const bf16x8 bf = *(const LAS bf16x8*)(lds + HG_BK + (16 * ss + lr) * 272 + (ks * 32 + 8 * lq) * 2);
                    acc = __builtin_amdgcn_mfma_f32_16x16x32_bf16(bf, af, acc, 0, 0, 0);
                }
            }
            const int t = 16 * tt + lr, s0 = 16 * ss + 4 * lq;
            float pv[4];
#pragma unroll
            for (int r = 0; r < 4; ++r) pv[r] = (s0 + r <= t) ? acc[r] : 0.f;
            u32x2 w; w.x = cvt_pk_bf16(pv[0], pv[1]); w.y = cvt_pk_bf16(pv[2], pv[3]);
            *(LAS u32x2*)(lds + HG_P + t * 144 + s0 * 2) = w;
        }
    }
    __syncthreads();
    f32x4 acc[4];
#pragma unroll
    for (int tt = 0; tt < 4; ++tt) acc[tt] = (f32x4){0.f, 0.f, 0.f, 0.f};
#pragma unroll
    for (int ks = 0; ks < 4; ++ks) {
        const bf16x8 sf = *(const LAS bf16x8*)(lds + HG_ST + (16 * wave + lr) * 272 + (ks * 32 + 8 * lq) * 2);
#pragma unroll
        for (int tt = 0; tt < 4; ++tt) { const bf16x8 af = *(const LAS bf16x8*)(lds + HG_A1 + (16 * tt + lr) * 272 + (ks * 32 + 8 * lq) * 2);
            acc[tt] = __builtin_amdgcn_mfma_f32_16x16x32_bf16(sf, af, acc[tt], 0, 0, 0); }
    }
#pragma unroll
    for (int ks = 0; ks < 2; ++ks) {
        const bf16x8 vf = *(const LAS bf16x8*)(lds + HG_VT + (16 * wave + lr) * 144 + (ks * 32 + 8 * lq) * 2);
#pragma unroll
        for (int tt = 0; tt < 4; ++tt) { const bf16x8 pf = *(const LAS bf16x8*)(lds + HG_P + (16 * tt + lr) * 144 + (ks * 32 + 8 * lq) * 2);
            acc[tt] = __builtin_amdgcn_mfma_f32_16x16x32_bf16(vf, pf, acc[tt], 0, 0, 0); }
    }
    LAS float* ssq = (LAS float*)(lds + HG_SSQ);
#pragma unroll
    for (int tt = 0; tt < 4; ++tt) { float s = (acc[tt].x * acc[tt].x + acc[tt].y * acc[tt].y) + (acc[tt].z * acc[tt].z + acc[tt].w * acc[tt].w);
        s += __shfl_xor(s, 16); s += __shfl_xor(s, 32); if (lq == 0) ssq[wave * 64 + 16 * tt + lr] = s; }
    __syncthreads();
    {
        const int col = h * 128 + 16 * wave + 4 * lq; const f32x4 hn = *(const f32x4*)(hg_norm + col);
#pragma unroll
        for (int tt = 0; tt < 4; ++tt) { const int t = 16 * tt + lr; float tot = 0.f;
#pragma unroll
            for (int w8 = 0; w8 < 8; ++w8) tot += ssq[w8 * 64 + t];
            const float rinv = rsqrtf(tot * (1.0f / 128.0f) + EPS);
            bf16_t* gp = GS + (size_t)(row0 + t) * HK + col; const u32x2 gw = *(const u32x2*)gp;
            u32x2 w; w.x = cvt_pk_bf16(acc[tt].x * rinv * hn.x * bf_lo(gw.x), acc[tt].y * rinv * hn.y * bf_hi(gw.x));
            w.y = cvt_pk_bf16(acc[tt].z * rinv * hn.z * bf_lo(gw.y), acc[tt].w * rinv * hn.w * bf_hi(gw.y));
            *(u32x2*)gp = w; }
    }
    __syncthreads();
}

__device__ __forceinline__ void sincos_d(double x, double& s, double& c) {
    const double kq = rint(x * 0.63661977236758134308);
    double r = fma(-kq, 1.57079632679489655800, x); r = fma(-kq, 6.12323399573676603587e-17, r);
    const double r2 = r * r;
    double sp = 1.0 / 6227020800.0; sp = fma(sp, r2, -1.0 / 39916800.0); sp = fma(sp, r2, 1.0 / 362880.0); sp = fma(sp, r2, -1.0 / 5040.0); sp = fma(sp, r2, 1.0 / 120.0); sp = fma(sp, r2, -1.0 / 6.0); sp = fma(sp * r2, r, r);
    double cp = -1.0 / 87178291200.0; cp = fma(cp, r2, 1.0 / 479001600.0); cp = fma(cp, r2, -1.0 / 3628800.0); cp = fma(cp, r2, 1.0 / 40320.0); cp = fma(cp, r2, -1.0 / 720.0); cp = fma(cp, r2, 1.0 / 24.0); cp = fma(cp, r2, -0.5); cp = fma(cp, r2, 1.0);
    const int q = ((int)kq) & 3;
    s = (q == 0) ? sp : (q == 1) ? cp : (q == 2) ? -sp : -cp;
    c = (q == 0) ? cp : (q == 1) ? -sp : (q == 2) ? -cp : sp;
}
struct S5In { const float *lam_re, *lam_im, *log_step, *b_re, *b_im, *c_re, *c_im, *d; };
__device__ __forceinline__ void s5_abar(const S5In& P, int g, int n, float& are, float& aim, float& cr, float& ci) {
    const float lr = P.lam_re[g * NS + n], li = P.lam_im[g * NS + n], dt = expf(P.log_step[g]);
    const float mag = expf(lr * dt); double s, c; sincos_d((double)li * (double)dt, s, c);
    const double ar = (double)mag * c, ai = (double)mag * s;
    are = (float)ar; aim = (float)ai;
    const double nr = ar - 1.0, ni = ai, den = (double)lr * lr + (double)li * li;
    cr = (float)((nr * lr + ni * li) / den); ci = (float)((ni * lr - nr * li) / den);
}
__device__ __forceinline__ void s5_setup(const S5In& P, int g, int lane, float& are, float& aim, float (&bbr)[16], float (&bbi)[16]) {
    float cr, ci; s5_abar(P, g, lane, are, aim, cr, ci);
    const f32x4* br = (const f32x4*)(P.b_re + (size_t)(g * NS + lane) * 16); const f32x4* bi = (const f32x4*)(P.b_im + (size_t)(g * NS + lane) * 16);
#pragma unroll
    for (int q = 0; q < 4; ++q) { const f32x4 r = br[q], i = bi[q];
#pragma unroll
        for (int e = 0; e < 4; ++e) { bbr[q * 4 + e] = cr * r[e] - ci * i[e]; bbi[q * 4 + e] = cr * i[e] + ci * r[e]; } }
}
#define S5_STEP4(uv)                                                                                                     \
    _Pragma("unroll") for (int j = 0; j < 4; ++j) {                                                                      \
        float bur = 0.f, bui = 0.f;                                                                                      \
        _Pragma("unroll") for (int p = 0; p < 16; ++p) { const float up = __int_as_float(__builtin_amdgcn_readlane(__float_as_int(uv), j * 16 + p)); bur = fmaf(up, bbr[p], bur); bui = fmaf(up, bbi[p], bui); } \
        const float nxr = are * xr - aim * xi + bur; xi = are * xi + aim * xr + bui; xr = nxr;                           \
        S5_EMIT(j) }
__device__ __forceinline__ void s5_local_item(const S5In& P, int item, const float* S5U, float* S5E, int lane) {
    const int c = item >> 5, g = item & 31; const int row0 = c == 0 ? MR : 64 * (c - 1), T = c == 0 ? NMETA : 64;
    float are, aim, bbr[16], bbi[16]; s5_setup(P, g, lane, are, aim, bbr, bbi);
    float xr = 0.f, xi = 0.f;
#define S5_EMIT(j)
    for (int tb = 0; tb < T; tb += 4) { const float uv = S5U[(size_t)(row0 + tb + (lane >> 4)) * S5W + g * 16 + (lane & 15)]; S5_STEP4(uv) }
#undef S5_EMIT
    *(float2*)(S5E + ((size_t)c * 2048 + g * NS + lane) * 2) = make_float2(xr, xi);
}
__device__ __forceinline__ float gelu_tanh(float x) { const float u = 0.7978845608028654f * (x + 0.044715f * x * x * x); const float th = 1.0f - 2.0f * __builtin_amdgcn_rcpf(1.0f + __expf(2.0f * u)); return 0.5f * x * (1.0f + th); }
__device__ __forceinline__ void s5_out_item(LAS unsigned char* xs, const S5In& P, int item, const float* S5U, const float* S5E, bf16_t* Z, int lane) {
    const int c = 1 + (item >> 5), g = item & 31, row0 = 64 * (c - 1), lr = lane & 15, lq = lane >> 4;
    float are, aim, bbr[16], bbi[16]; s5_setup(P, g, lane, are, aim, bbr, bbi);
    bf16x8 cf[4];
#pragma unroll
    for (int ks = 0; ks < 4; ++ks) { const float* src = (ks < 2 ? P.c_re : P.c_im) + (size_t)(g * 16 + lr) * NS + (ks & 1) * 32 + 8 * lq; const float sg = ks < 2 ? 1.f : -1.f;
        const f32x4 a = *(const f32x4*)src, b = *(const f32x4*)(src + 4);
        u32x4 w; w.x = cvt_pk_bf16(sg * a.x, sg * a.y); w.y = cvt_pk_bf16(sg * a.z, sg * a.w); w.z = cvt_pk_bf16(sg * b.x, sg * b.y); w.w = cvt_pk_bf16(sg * b.z, sg * b.w);
        cf[ks] = __builtin_bit_cast(bf16x8, w); }
    const f32x4 dk = *(const f32x4*)(P.d + g * 16 + 4 * lq);
    const float2 x0 = *(const float2*)(S5E + ((size_t)c * 2048 + g * NS + lane) * 2);
    float xr = x0.x, xi = x0.y;
    for (int blk = 0; blk < 4; ++blk) {
#define S5_EMIT(j) { const unsigned pk = cvt_pk_bf16(xr, xi); *(LAS bf16_t*)(xs + (sub * 4 + j) * 272 + lane * 2) = (bf16_t)(pk & 0xffffu); *(LAS bf16_t*)(xs + (sub * 4 + j) * 272 + 128 + lane * 2) = (bf16_t)(pk >> 16); }
#pragma unroll
        for (int sub = 0; sub < 4; ++sub) { const float uv = S5U[(size_t)(row0 + blk * 16 + sub * 4 + (lane >> 4)) * S5W + g * 16 + (lane & 15)]; S5_STEP4(uv) }
#undef S5_EMIT
        LDS_WAIT(); __builtin_amdgcn_wave_barrier();
        f32x4 acc = (f32x4){0.f, 0.f, 0.f, 0.f};
#pragma unroll
        for (int ks = 0; ks < 4; ++ks) { const bf16x8 xf = *(const LAS bf16x8*)(xs + lr * 272 + (ks * 32 + 8 * lq) * 2); acc = __builtin_amdgcn_mfma_f32_16x16x32_bf16(cf[ks], xf, acc, 0, 0, 0); }
        const size_t row = (size_t)(row0 + blk * 16 + lr);
        const f32x4 u4 = *(const f32x4*)(S5U + row * S5W + g * 16 + 4 * lq);
        u32x2 w; w.x = cvt_pk_bf16(gelu_tanh(acc.x + dk.x * u4.x), gelu_tanh(acc.y + dk.y * u4.y)); w.y = cvt_pk_bf16(gelu_tanh(acc.z + dk.z * u4.z), gelu_tanh(acc.w + dk.w * u4.w));
        *(u32x2*)(Z + row * S5W + g * 16 + 4 * lq) = w;
        LDS_WAIT(); __builtin_amdgcn_wave_barrier();
    }
}

__global__ void __launch_bounds__(512, 2) fwd(Args a) {
    __shared__ __attribute__((aligned(16))) unsigned char lds_raw[LDS_BYTES];
    LAS unsigned char* lds = (LAS unsigned char*)lds_raw;
    const int tid = threadIdx.x, lane = tid & 63, wave = __builtin_amdgcn_readfirstlane(tid >> 6);
    const int G = gridDim.x, bx = blockIdx.x, gw = bx * 8 + wave, NGW = G * 8;
    unsigned char* ws = a.ws;
    const float* x = a.in[0]; const float* meta = a.in[1];
    bf16_t* WGU = (bf16_t*)(ws + WS_WGU); bf16_t* WD = (bf16_t*)(ws + WS_WD); bf16_t* WIN = (bf16_t*)(ws + WS_WIN); bf16_t* WHG = (bf16_t*)(ws + WS_WHG);
    bf16_t* WGLU = (bf16_t*)(ws + WS_WGLU); bf16_t* WOUT = (bf16_t*)(ws + WS_WOUT);
    float* HRES = (float*)(ws + WS_HRES); bf16_t* ABUF = (bf16_t*)(ws + WS_ABUF);
    bf16_t* Qb = (bf16_t*)(ws + WS_Q); bf16_t* Kb = (bf16_t*)(ws + WS_K); float* LOGF = (float*)(ws + WS_LOGF); bf16_t* Vb = (bf16_t*)(ws + WS_V); bf16_t* GS = (bf16_t*)(ws + WS_GS);
    float* S5U = (float*)(ws + WS_S5U); bf16_t* Z = (bf16_t*)(ws + WS_Z); float* PARTA = (float*)(ws + WS_PARTA); float* PARTB = (float*)(ws + WS_PARTB);
    float* DEC = (float*)(ws + WS_DEC); float* S5E = (float*)(ws + WS_S5E); bf16_t* Hh = (bf16_t*)(ws + WS_H); bf16_t* GATES = (bf16_t*)(ws + WS_GATES);
    bf16_t* ST = (bf16_t*)a.out; bf16_t* YS = (bf16_t*)((unsigned char*)a.out + DO_YS); bf16_t* MERGED = (bf16_t*)((unsigned char*)a.out + DO_MERGED);
    S5In s5p{a.in[11], a.in[12], a.in[13], a.in[14], a.in[15], a.in[16], a.in[17], a.in[18]};
    const int lo = a.lo, hi = a.hi;
    cg::grid_group grid = cg::this_grid();
#define IN(k) (lo <= (k) && (k) < hi)
#define SEAM(k) do { if (IN((k) + 1)) grid.sync(); } while (0)
    LAS float* scr = (LAS float*)(lds + wave * 8448);

    if (IN(0)) {
        int it = gw;
        tr_run(TrJob{a.in[3], D, FF, WGU, a.in[2], 1}, it, NGW, scr, lane);
        tr_run(TrJob{a.in[4], D, FF, WGU, a.in[2], 2}, it, NGW, scr, lane);
        tr_run(TrJob{a.in[5], FF, D, WD, nullptr, 0}, it, NGW, scr, lane);
        tr_run(TrJob{a.in[7], D, INCOLS, WIN, a.in[6], 0}, it, NGW, scr, lane);
        tr_run(TrJob{a.in[10], HK, D, WHG, nullptr, 0}, it, NGW, scr, lane);
        tr_run(TrJob{a.in[19], S5W, D, WGLU, nullptr, 1}, it, NGW, scr, lane);
        tr_run(TrJob{a.in[20], S5W, D, WGLU, nullptr, 2}, it, NGW, scr, lane);
        tr_run(TrJob{a.in[21], D, D, WOUT, nullptr, 0}, it, NGW, scr, lane);
        for (int row = gw; row < MP; row += NGW) {
            const float* src = row < MR ? x + (size_t)row * D : (row < MR + NMETA ? meta + (size_t)(row - MR) * D : nullptr);
            float ss = 0.f;
#pragma unroll
            for (int j = 0; j < 8; ++j) { const f32x4 v = src ? *(const f32x4*)(src + 4 * lane + 256 * j) : (f32x4){0.f, 0.f, 0.f, 0.f};
                ss += (v.x * v.x + v.y * v.y) + (v.z * v.z + v.w * v.w);
                u32x2 w; w.x = cvt_pk_bf16(v.x, v.y); w.y = cvt_pk_bf16(v.z, v.w); *(u32x2*)(ABUF + (size_t)row * D + 4 * lane + 256 * j) = w; }
            ss = wave_sum(ss);
            if (lane < 32) PARTA[(size_t)row * 32 + lane] = lane == 0 ? ss : 0.f;
        }
        SEAM(0);
    }
    if (IN(1)) { pg8::Gemm g{ABUF, WGU, MP, 2 * FF, D}; pg8::StaticOrder S; S.init(MP, 2 * FF, G, bx); EpiSwiglu E{Hh, PARTA}; pg8::gemm_phase(lds, g, S, E); SEAM(1); }
    if (IN(2)) { pg8::Gemm g{Hh, WD, MP, D, FF}; pg8::StaticOrder S; S.init(MP, D, G, bx); EpiRes E{nullptr, x, meta, HRES, ABUF, PARTB, 0.5f, 0}; pg8::gemm_phase(lds, g, S, E); SEAM(2); }
    if (IN(3)) { pg8::Gemm g{ABUF, WIN, MP, NREC, D}; pg8::StaticOrder S; S.init(MP, NREC, G, bx); EpiRec E{Qb, Kb, Vb, GS, LOGF, S5U, PARTB, a.in[8]}; pg8::gemm_phase(lds, g, S, E); SEAM(3); }
    if (IN(4)) {
#ifndef DBG_NO_HGL
        for (int item = bx; item < NCH * NH; item += G) hg_local_item(lds, item, LOGF, Kb, Vb, ST, DEC, tid, wave, lane);
#endif
#ifndef DBG_NO_S5L
        for (int item = gw; item < 128 * 32; item += NGW) s5_local_item(s5p, item, S5U, S5E, lane);
#endif
        SEAM(4);
    }
    if (IN(5)) {
        const int gt = bx * 512 + tid;
        if (gt < 98304) {
            unsigned* S32 = (unsigned*)ST; const int e = gt, h = e >> 13, k = (e & 63) * 2;
            float s0 = 0.f, s1 = 0.f;
            for (int cb = 0; cb < 128; cb += 8) {
                unsigned w[8]; float2 d[8];
#pragma unroll
                for (int j = 0; j < 8; ++j) { w[j] = S32[(size_t)(cb + j) * 98304 + e]; d[j] = *(const float2*)(DEC + (size_t)((cb + j) * NH + h) * 128 + k); }
#pragma unroll
                for (int j = 0; j < 8; ++j) { S32[(size_t)(cb + j) * 98304 + e] = cvt_pk_bf16(s0, s1); s0 = fmaf(d[j].x, s0, bf_lo(w[j])); s1 = fmaf(d[j].y, s1, bf_hi(w[j])); }
            }
            S32[(size_t)128 * 98304 + e] = cvt_pk_bf16(s0, s1);
        } else if (gt < 98304 + 2048) {
            const int ch = gt - 98304; float ar, ai, cr, ci; s5_abar(s5p, ch >> 6, ch & 63, ar, ai, cr, ci);
#pragma unroll
            for (int q = 0; q < 6; ++q) { const float nr = ar * ar - ai * ai; ai = 2.f * ar * ai; ar = nr; }
            float xr = 0.f, xi = 0.f;
            for (int c = 0; c < 128; ++c) { float2* p = (float2*)(S5E + ((size_t)c * 2048 + ch) * 2); const float2 ev = *p; *p = make_float2(xr, xi);
                const float nxr = ar * xr - ai * xi + ev.x; xi = ar * xi + ai * xr + ev.y; xr = nxr; }
            *(float2*)(S5E + ((size_t)128 * 2048 + ch) * 2) = make_float2(xr, xi);
        }
        int it = gw;
        tr_run(TrJob{a.in[23], D, FF, WGU, a.in[22], 1}, it, NGW, scr, lane);
        tr_run(TrJob{a.in[24], D, FF, WGU, a.in[22], 2}, it, NGW, scr, lane);
        tr_run(TrJob{a.in[25], FF, D, WD, nullptr, 0}, it, NGW, scr, lane);
        SEAM(5);
    }
    if (IN(6)) {
        for (int item = bx; item < 128 * NH; item += G) hg_out_item(lds, item, LOGF, Qb, Kb, Vb, ST, GS, a.in[9], tid, wave, lane);
        for (int item = gw; item < 128 * 32; item += NGW) s5_out_item(lds + wave * 4352, s5p, item, S5U, S5E, Z, lane);
        SEAM(6);
    }
    if (IN(7)) { pg8::Gemm g{ABUF, WIN + (size_t)NREC * D, MR, NGATE, D}; pg8::StaticOrder S; S.init(MR, NGATE, G, bx); EpiGates E{GATES, PARTB}; pg8::gemm_phase(lds, g, S, E); SEAM(7); }
    if (IN(8)) { pg8::Gemm g{Z, WGLU, MR, 2 * D, S5W}; pg8::StaticOrder S; S.init(MR, 2 * D, G, bx); EpiGlu E{GATES, YS}; pg8::gemm_phase(lds, g, S, E); SEAM(8); }
    if (IN(9)) { pg8::Gemm g{GS, WHG, MR, D, HK}; pg8::StaticOrder S; S.init(MR, D, G, bx); EpiMerge E{GATES, YS, MERGED}; pg8::gemm_phase(lds, g, S, E); SEAM(9); }
    if (IN(10)) { pg8::Gemm g{MERGED, WOUT, MR, D, D}; pg8::StaticOrder S; S.init(MR, D, G, bx); EpiRes E{HRES, x, meta, HRES, ABUF, PARTA, 1.0f, 1}; pg8::gemm_phase(lds, g, S, E); SEAM(10); }
    if (IN(11)) { pg8::Gemm g{ABUF, WGU, MR, 2 * FF, D}; pg8::StaticOrder S; S.init(MR, 2 * FF, G, bx); EpiSwiglu E{Hh, PARTA}; pg8::gemm_phase(lds, g, S, E); SEAM(11); }
    if (IN(12)) { pg8::Gemm g{Hh, WD, MR, D, FF}; pg8::StaticOrder S; S.init(MR, D, G, bx); EpiRes E{HRES, x, meta, a.out, nullptr, PARTB, 0.5f, 1}; pg8::gemm_phase(lds, g, S, E); SEAM(12); }
    if (IN(13)) {
        const float* gf = a.in[26];
        for (int row = gw; row < MR; row += NGW) {
            const float pv = lane < 32 ? PARTB[(size_t)row * 32 + lane] : 0.f; const float rstd = rsqrtf(wave_sum(pv) * (1.0f / D) + EPS);
            float* o = a.out + (size_t)row * D;
#pragma unroll
            for (int j = 0; j < 8; ++j) { f32x4 v = *(f32x4*)(o + 4 * lane + 256 * j); const f32x4 gg = *(const f32x4*)(gf + 4 * lane + 256 * j);
                v.x *= rstd * gg.x; v.y *= rstd * gg.y; v.z *= rstd * gg.z; v.w *= rstd * gg.w; *(f32x4*)(o + 4 * lane + 256 * j) = v; }
        }
    }
#undef IN
#undef SEAM
}


#ifdef DBG_STOP
struct DbgReg { const unsigned* p; size_t nwords; };
struct DbgArgs { DbgReg r[24]; int n; int pad; unsigned* sums; };
__global__ void dbg_sum(DbgArgs d) {
    for (int i = 0; i < d.n; ++i) { unsigned s = 0; for (size_t w = (size_t)blockIdx.x * blockDim.x + threadIdx.x; w < d.r[i].nwords; w += (size_t)gridDim.x * blockDim.x) s += d.r[i].p[w] * 2654435761u + (unsigned)w;
        for (int o = 1; o < 64; o <<= 1) s += __shfl_xor(s, o);
        if ((threadIdx.x & 63) == 0) atomicAdd(d.sums + i, s); }
}
__global__ void dbg_fill(float* out, const unsigned* sums, int n, size_t total) {
    for (size_t w = (size_t)blockIdx.x * blockDim.x + threadIdx.x; w < total; w += (size_t)gridDim.x * blockDim.x) out[w] = w < (size_t)n ? (float)(sums[w] & 0xFFFFFu) : 0.f;
}
#endif
constexpr int NPHASES = 14;
extern "C" void kernel_launch(void* const* d_in, const int* in_sizes, int n_in, void* d_out, int out_size, void* d_ws, size_t ws_size, hipStream_t stream) {
    static int grid = 0;
    if (grid == 0) {
        if (n_in != 27 || out_size != MR * D || ws_size < WS_END + 256) { fprintf(stderr, "kernel_launch: unexpected shapes (n_in %d out %d ws %zu need %zu)\n", n_in, out_size, ws_size, (size_t)WS_END); grid = -1; return; }
        int dev = 0, cus = 0, per_cu = 0;
        (void)hipGetDevice(&dev); (void)hipDeviceGetAttribute(&cus, hipDeviceAttributeMultiprocessorCount, dev);
        if (hipOccupancyMaxActiveBlocksPerMultiprocessor(&per_cu, (const void*)fwd, 512, 0) != hipSuccess || per_cu < 1) { fprintf(stderr, "kernel_launch: occupancy query gave %d\n", per_cu); per_cu = 1; }
        (void)hipGetLastError();
        grid = cus * 1;
        fprintf(stderr, "kernel_launch: grid %d (cus %d, per_cu %d), ws %zu need %zu\n", grid, cus, per_cu, ws_size, (size_t)WS_END);
    }
    if (grid < 0) return;
    Args a{};
    for (int i = 0; i < 27; ++i) a.in[i] = (const float*)d_in[i];
    a.out = (float*)d_out; a.ws = (unsigned char*)d_ws;
#if MK_MULTI
#ifdef DBG_STOP
    for (int p = 0; p <= DBG_STOP; ++p) { a.lo = p; a.hi = p + 1; hipLaunchKernelGGL(fwd, dim3(grid), dim3(512), 0, stream, a); }
    {
        unsigned char* ws = (unsigned char*)d_ws; DbgArgs d{}; int n = 0;
        auto add = [&](size_t off, size_t bytes) { d.r[n].p = (const unsigned*)(ws + off); d.r[n].nwords = bytes / 4; ++n; };
        const int sel = DBG_SEL;
        if (sel & 1) { add(WS_WGU, (size_t)2 * FF * D * 2); add(WS_WD, (size_t)D * FF * 2); add(WS_WIN, (size_t)INCOLS * D * 2); add(WS_WHG, (size_t)D * HK * 2); add(WS_WGLU, (size_t)2 * D * S5W * 2); add(WS_WOUT, (size_t)D * D * 2); }
        if (sel & 2) { add(WS_HRES, (size_t)MP * D * 4); add(WS_ABUF, (size_t)MP * D * 2); add(WS_PARTB, (size_t)MP * 32 * 4); }
        if (sel & 4) { add(WS_Q, (size_t)MP * HK * 2); add(WS_K, (size_t)MP * HK * 2); add(WS_V, (size_t)MP * HK * 2); add(WS_S5U, (size_t)MP * S5W * 4); }
        if (sel & 8) { add(WS_LOGF, (size_t)(MR + NMETA) * HK * 4); add(WS_DEC, (size_t)128 * NH * 128 * 4); }
        if (sel & 128) { add(WS_S5E, (size_t)128 * 2048 * 8); }
        if (sel & 16) { add(WS_GS, (size_t)MR * HK * 2); add(WS_Z, (size_t)MR * S5W * 2); }
        if (sel & 64) { add(WS_LOGF, (size_t)(MR + NMETA) * HK * 4); add(WS_GS, (size_t)MP * HK * 2); }
        if (sel & 32) { d.r[n].p = (const unsigned*)d_out; d.r[n].nwords = (size_t)128 * NH * 16384 * 2 / 4; ++n; }
        d.n = n; d.sums = (unsigned*)(ws + WS_END);
        hipMemsetAsync(ws + WS_END, 0, 256, stream);
        hipLaunchKernelGGL(dbg_sum, dim3(1024), dim3(256), 0, stream, d);
        hipLaunchKernelGGL(dbg_fill, dim3(1024), dim3(256), 0, stream, (float*)d_out, (const unsigned*)(ws + WS_END), n, (size_t)MR * D);
    }
#else
    for (int p = 0; p < NPHASES; ++p) { a.lo = p; a.hi = p + 1; hipLaunchKernelGGL(fwd, dim3(grid), dim3(512), 0, stream, a); }
#endif
#else
    a.lo = 0; a.hi = NPHASES;
    void* args[] = {&a};
    hipError_t e = hipLaunchCooperativeKernel((const void*)fwd, dim3(grid), dim3(512), args, 0, stream);
    if (e != hipSuccess) fprintf(stderr, "kernel_launch: cooperative launch failed: %s (grid %d)\n", hipGetErrorString(e), grid);
#endif
}
```

```cpp
#include <hip/hip_runtime.h>
#include <hip/hip_cooperative_groups.h>
#include <cstdio>
namespace cg = cooperative_groups;

#ifndef MK_MULTI
#define MK_MULTI 0
#endif

namespace pg8 {
#define PG8_LAS __attribute__((address_space(3)))
typedef unsigned short bf16_t;
typedef short bf16x8 __attribute__((ext_vector_type(8)));
typedef float f32x4 __attribute__((ext_vector_type(4)));
typedef unsigned u32x4 __attribute__((ext_vector_type(4)));
typedef unsigned u32x2 __attribute__((ext_vector_type(2)));
constexpr int BM = 256, BK = 64, HALF = 128, HTB = HALF * BK * 2  , STAGE_BYTES = 8 * HTB, NXCD = 8, WGM = 8;

__host__ __device__ __forceinline__ int lds_byte(int r, int c) { const int st = (r >> 4) * 2 + (c >> 5), rr = r & 15, cc = c & 31, ob = rr * 64 + cc * 2; return st * 1024 + (ob ^ (((ob >> 9) & 1) << 5)); }
__host__ __device__ __forceinline__ void stage_rc(int b, int& R, int& C) { const int st = b / 1024, sb = b % 1024, swz = sb ^ (((sb >> 9) & 1) << 5); R = (st >> 1) * 16 + swz / 64; C = (st & 1) * 32 + (swz % 64) / 2; }
__host__ __device__ __forceinline__ int perm32(int rho) { const int n = rho >> 4, i = rho & 15; return 8 * (i >> 2) + 4 * n + (i & 3); }

struct Unit { int pm, pn; };
struct Gemm { const bf16_t* A; const bf16_t* Bt; int M, N, K; };

struct StaticOrder {
    int nM, nN, nwg, G, c;
    __host__ __device__ void init(int M, int N, int G_, int c_) { nM = M / BM; nN = N / BM; nwg = nM * nN; G = G_; c = c_; }
    __host__ __device__ bool next(int i, Unit& u) const {
        const long L = (long)i * G + c; if (L >= nwg) return false;
        int wgid = (int)L; { const int q = nwg / NXCD, r = nwg % NXCD, xcd = wgid % NXCD, off = wgid / NXCD; wgid = (xcd < r ? xcd * (q + 1) : r * (q + 1) + (xcd - r) * q) + off; }
        const int nig = WGM * nN, gid = wgid / nig, fm = gid * WGM, gsz = (nM - fm) < WGM ? (nM - fm) : WGM;
        u.pm = fm + ((wgid % nig) % gsz); u.pn = (wgid % nig) / gsz; return true;
    }
    __device__ __forceinline__ void a_ready(const Unit&) const {}
    __device__ __forceinline__ void done(const Unit&) const {}
};
typedef float f32x2v __attribute__((ext_vector_type(2)));
typedef __bf16 bf16x2v __attribute__((ext_vector_type(2)));
__device__ __forceinline__ unsigned cvt_pk_bf16(float lo, float hi) { const f32x2v v = {lo, hi}; const bf16x2v b = __builtin_convertvector(v, bf16x2v); return __builtin_bit_cast(unsigned, b); }

template <class Epi, class Sched>
__device__ __forceinline__ void gemm_phase(PG8_LAS unsigned char* lds, const Gemm g, const Sched& S, const Epi& E) {
    const int tid = threadIdx.x, wid = __builtin_amdgcn_readfirstlane(tid >> 6), lane = tid & 63, wr = wid >> 2, wc = wid & 3, fr = lane & 15, fq = lane >> 4;
    const int K = g.K, nt = K / BK;
    unsigned voffA[2], voffB[2];
#pragma unroll
    for (int i = 0; i < 2; ++i) { int R, C; stage_rc(tid * 16 + i * 8192, R, C); const int Rb = Epi::PERM ? ((R & ~31) + perm32(R & 31)) : R;
        voffA[i] = (unsigned)(R * K + C) * 2u; voffB[i] = (unsigned)(Rb * K + C) * 2u; }
    const size_t kstep = (size_t)(BK * 2);
    const size_t hstep = (size_t)HALF * K * 2;
    const size_t tstep = 2 * hstep;
    const unsigned ldsw = (unsigned)wid * 1024u;
    const int aoff = lds_byte(wr * 64 + fr, fq * 8), boff = lds_byte(wc * 32 + fr, fq * 8);
#define PG8_SA(b, h) (((b) * 2 + (h)) * HTB)
#define PG8_SB(b, h) ((4 + (b) * 2 + (h)) * HTB)
#define PG8_STAGE(bufoff, gbase, voff) do { _Pragma("unroll") for (int _i = 0; _i < 2; ++_i) \
        __builtin_amdgcn_global_load_lds((const unsigned*)((const char*)(gbase) + (voff)[_i]), (PG8_LAS unsigned*)(lds + (bufoff) + ldsw + _i * 8192), 16, 0, 0); } while (0)
#define PG8_LDA(dst, b, h) do { _Pragma("unroll") for (int m = 0; m < 4; ++m) _Pragma("unroll") for (int k = 0; k < 2; ++k) dst[m][k] = *(const PG8_LAS bf16x8*)(lds + PG8_SA(b, h) + aoff + m * 2048 + k * 1024); } while (0)
#define PG8_LDB(dst, b, h) do { _Pragma("unroll") for (int n = 0; n < 2; ++n) _Pragma("unroll") for (int k = 0; k < 2; ++k) dst[n][k] = *(const PG8_LAS bf16x8*)(lds + PG8_SB(b, h) + boff + n * 2048 + k * 1024); } while (0)
#define PG8_MMA(ai, bj, At, Bt) do { __builtin_amdgcn_s_setprio(1); _Pragma("unroll") for (int m = 0; m < 4; ++m) _Pragma("unroll") for (int n = 0; n < 2; ++n) _Pragma("unroll") for (int k = 0; k < 2; ++k) \
        acc[ai][bj][m][n] = __builtin_amdgcn_mfma_f32_16x16x32_bf16(Bt[n][k], At[m][k], acc[ai][bj][m][n], 0, 0, 0); __builtin_amdgcn_s_setprio(0); } while (0)
#define PG8_WAIT_V(n) asm volatile("s_waitcnt vmcnt(" #n ")" ::: "memory")
#define PG8_WAIT_L(n) asm volatile("s_waitcnt lgkmcnt(" #n ")" ::: "memory")
#define PG8_BAR __builtin_amdgcn_s_barrier()
#define PG8_SCHED __builtin_amdgcn_sched_barrier(0)
    Unit cur, nxt; int ui = 0;
    if (!S.next(0, cur)) return;
    f32x4 acc[2][2][4][2];
#pragma unroll
    for (int a = 0; a < 2; ++a)
#pragma unroll
        for (int b = 0; b < 2; ++b)
#pragma unroll
            for (int m = 0; m < 4; ++m)
#pragma unroll
                for (int n = 0; n < 2; ++n) acc[a][b][m][n] = (f32x4){0.f, 0.f, 0.f, 0.f};
    bf16x8 At[4][2], B0[2][2], B1[2][2];
    const char* cA = (const char*)g.A + (size_t)cur.pm * tstep; const char* cB = (const char*)g.Bt + (size_t)cur.pn * tstep;
    S.a_ready(cur);
    PG8_STAGE(PG8_SB(0, 0), cB, voffB); PG8_STAGE(PG8_SA(0, 0), cA, voffA); PG8_STAGE(PG8_SB(0, 1), cB + hstep, voffB); PG8_STAGE(PG8_SA(0, 1), cA + hstep, voffA);
    if (wr == 1) PG8_BAR;
    PG8_WAIT_V(4); PG8_BAR;
    PG8_STAGE(PG8_SB(1, 0), cB + kstep, voffB); PG8_STAGE(PG8_SA(1, 0), cA + kstep, voffA); PG8_STAGE(PG8_SB(1, 1), cB + hstep + kstep, voffB);
    PG8_WAIT_V(6); PG8_BAR;
    for (;;) {
        const bool has_next = S.next(ui + 1, nxt);
        const char* nA = has_next ? (const char*)g.A + (size_t)nxt.pm * tstep : cA; const char* nB = has_next ? (const char*)g.Bt + (size_t)nxt.pn * tstep : cB;
        for (int t = 0; t < nt; t += 2) {
            const bool last = (t == nt - 2);
            const char* a1 = cA + (size_t)(t + 1) * kstep;
            const char* a2 = last ? nA : cA + (size_t)(t + 2) * kstep; const char* b2 = last ? nB : cB + (size_t)(t + 2) * kstep;
            const char* a3 = a2 + kstep; const char* b3 = b2 + kstep;
            if (last && has_next) S.a_ready(nxt);
            PG8_LDB(B0, 0, 0); PG8_SCHED; PG8_LDA(At, 0, 0); PG8_STAGE(PG8_SA(1, 1), a1 + hstep, voffA);
            PG8_WAIT_L(8); PG8_BAR; PG8_WAIT_L(0); PG8_MMA(0, 0, At, B0); PG8_BAR; PG8_SCHED;
            PG8_LDB(B1, 0, 1); PG8_STAGE(PG8_SB(0, 0), b2, voffB);
            PG8_BAR; PG8_WAIT_L(0); PG8_MMA(0, 1, At, B1); PG8_BAR;
            PG8_LDA(At, 0, 1); PG8_STAGE(PG8_SA(0, 0), a2, voffA);
            PG8_BAR; PG8_WAIT_L(0); PG8_MMA(1, 0, At, B0); PG8_BAR; PG8_SCHED;
            PG8_STAGE(PG8_SB(0, 1), b2 + hstep, voffB);
            PG8_WAIT_V(6); PG8_BAR; PG8_MMA(1, 1, At, B1); PG8_BAR;
            PG8_LDB(B0, 1, 0); PG8_SCHED; PG8_LDA(At, 1, 0); PG8_STAGE(PG8_SA(0, 1), a2 + hstep, voffA);
            PG8_WAIT_L(8); PG8_BAR; PG8_WAIT_L(0); PG8_MMA(0, 0, At, B0); PG8_BAR; PG8_SCHED;
            PG8_LDB(B1, 1, 1); PG8_STAGE(PG8_SB(1, 0), b3, voffB);
            PG8_BAR; PG8_WAIT_L(0); PG8_MMA(0, 1, At, B1); PG8_BAR;
            PG8_LDA(At, 1, 1); PG8_STAGE(PG8_SA(1, 0), a3, voffA);
            PG8_BAR; PG8_WAIT_L(0); PG8_MMA(1, 0, At, B0); PG8_BAR; PG8_SCHED;
            PG8_STAGE(PG8_SB(1, 1), b3 + hstep, voffB);
            PG8_WAIT_V(6); PG8_BAR; PG8_MMA(1, 1, At, B1); PG8_BAR;
        }
        if constexpr (!Epi::AFTER_DRAIN) { E(acc, cur, wr, wc, fr, fq); S.done(cur); }
        if (!has_next) break;
#pragma unroll
        for (int a = 0; a < 2; ++a)
#pragma unroll
            for (int b = 0; b < 2; ++b)
#pragma unroll
                for (int m = 0; m < 4; ++m)
#pragma unroll
                    for (int n = 0; n < 2; ++n) acc[a][b][m][n] = (f32x4){0.f, 0.f, 0.f, 0.f};
        cur = nxt; cA = nA; cB = nB; ++ui;
    }
    PG8_WAIT_V(0);
    if (wr == 0) PG8_BAR;
    PG8_BAR;
    if constexpr (Epi::AFTER_DRAIN) { E.fused(acc, cur, wr, wc, fr, fq, lds, wid, lane); S.done(cur); }
#undef PG8_SA
#undef PG8_SB
#undef PG8_STAGE
#undef PG8_LDA
#undef PG8_LDB
#undef PG8_MMA
#undef PG8_WAIT_V
#undef PG8_WAIT_L
#undef PG8_BAR
#undef PG8_SCHED
}
}

using pg8::bf16_t; using pg8::bf16x8; using pg8::f32x4; using pg8::u32x4; using pg8::u32x2; using pg8::cvt_pk_bf16;
#define LAS __attribute__((address_space(3)))
constexpr int D = 2048, FF = 5632, MR = 8192, NMETA = 16, MP = 8448;
constexpr int HK = 1536, NH = 12, S5W = 512, NS = 64;
constexpr int NREC = 6656, NGATE = 4096, INCOLS = 10752, NCH = 129;
constexpr float EPS = 1e-6f;
constexpr int LDS_BYTES = 131072;

constexpr size_t WS_WGU  = 0;
constexpr size_t WS_WD   = WS_WGU  + (size_t)2 * FF * D * 2;
constexpr size_t WS_WIN  = WS_WD   + (size_t)D * FF * 2;
constexpr size_t WS_WHG  = WS_WIN  + (size_t)INCOLS * D * 2;
constexpr size_t WS_WGLU = WS_WHG  + (size_t)D * HK * 2;
constexpr size_t WS_WOUT = WS_WGLU + (size_t)2 * D * S5W * 2;
constexpr size_t WS_HRES = WS_WOUT + (size_t)D * D * 2;
constexpr size_t WS_ABUF = WS_HRES + (size_t)MP * D * 4;
constexpr size_t WS_Q    = WS_ABUF + (size_t)MP * D * 2;
constexpr size_t WS_K    = WS_Q    + (size_t)MP * HK * 2;
constexpr size_t WS_LOGF = WS_K    + (size_t)MP * HK * 2;
constexpr size_t WS_V    = WS_LOGF + (size_t)MP * HK * 4;
constexpr size_t WS_GS   = WS_V    + (size_t)MP * HK * 2;
constexpr size_t WS_S5U  = WS_GS   + (size_t)MP * HK * 2;
constexpr size_t WS_Z    = WS_S5U  + (size_t)MP * S5W * 4;
constexpr size_t WS_PARTA= WS_Z    + (size_t)MR * S5W * 2;
constexpr size_t WS_PARTB= WS_PARTA+ (size_t)MP * 32 * 4;
constexpr size_t WS_DEC  = WS_PARTB+ (size_t)MP * 32 * 4;
constexpr size_t WS_S5E  = WS_DEC  + (size_t)128 * NH * 128 * 4;
constexpr size_t WS_END  = WS_S5E  + (size_t)NCH * 2048 * 8;
constexpr size_t WS_H     = WS_Q;
constexpr size_t WS_GATES = WS_Q;
static_assert((size_t)MP * FF * 2 <= WS_V - WS_Q, "H alias");
constexpr size_t DO_YS = 0, DO_MERGED = (size_t)MR * D * 2;

struct Args { const float* in[27]; float* out; unsigned char* ws; int lo, hi; };

__device__ __forceinline__ float bf_lo(unsigned w) { return __uint_as_float(w << 16); }
__device__ __forceinline__ float bf_hi(unsigned w) { return __uint_as_float(w & 0xffff0000u); }
__device__ __forceinline__ float bf2f(bf16_t b) { return __uint_as_float(((unsigned)b) << 16); }
__device__ __forceinline__ float fsigmoid(float x) { return __builtin_amdgcn_rcpf(1.0f + __expf(-x)); }
__device__ __forceinline__ float fsilu(float x) { return x * fsigmoid(x); }
#define LDS_WAIT() asm volatile("s_waitcnt lgkmcnt(0)" ::: "memory")

__device__ __forceinline__ void row_rstd(const float* part, int row0, int fq, float (&rs)[2][4]) {
#pragma unroll
    for (int ai = 0; ai < 2; ++ai)
#pragma unroll
        for (int m = 0; m < 4; ++m) {
            const f32x4* p = (const f32x4*)(part + (size_t)(row0 + ai * 128 + m * 16) * 32 + fq * 8);
            const f32x4 a = p[0], b = p[1];
            float s = ((a.x + a.y) + (a.z + a.w)) + ((b.x + b.y) + (b.z + b.w));
            s += __shfl_xor(s, 16); s += __shfl_xor(s, 32);
            rs[ai][m] = rsqrtf(s * (1.0f / D) + EPS);
        }
}
struct EpiSwiglu {
    static constexpr bool PERM = true, AFTER_DRAIN = false;
    bf16_t* H; const float* part;
    __device__ __forceinline__ void operator()(const f32x4 (&acc)[2][2][4][2], const pg8::Unit& u, int wr, int wc, int fr, int fq) const {
        const int row0 = u.pm * 256 + wr * 64 + fr, col0 = u.pn * 128 + wc * 32 + 8 * fq;
        float rs[2][4]; row_rstd(part, row0, fq, rs);
#pragma unroll
        for (int ai = 0; ai < 2; ++ai)
#pragma unroll
            for (int m = 0; m < 4; ++m) {
                const float r = rs[ai][m]; float h[8];
#pragma unroll
                for (int n = 0; n < 2; ++n)
#pragma unroll
                    for (int j = 0; j < 4; ++j) h[n * 4 + j] = fsilu(acc[ai][0][m][n][j] * r) * (acc[ai][1][m][n][j] * r);
                u32x4 w; w.x = cvt_pk_bf16(h[0], h[1]); w.y = cvt_pk_bf16(h[2], h[3]); w.z = cvt_pk_bf16(h[4], h[5]); w.w = cvt_pk_bf16(h[6], h[7]);
                *(u32x4*)(H + (size_t)(row0 + ai * 128 + m * 16) * FF + col0) = w;
            }
    }
};
struct EpiRes {
    static constexpr bool PERM = false, AFTER_DRAIN = false;
    const float* res; const float* x; const float* meta; float* out; bf16_t* outb; float* part; float alpha; int mode;
    __device__ __forceinline__ void operator()(const f32x4 (&acc)[2][2][4][2], const pg8::Unit& u, int wr, int wc, int fr, int fq) const {
        const int row0 = u.pm * 256 + wr * 64 + fr, col0 = u.pn * 256 + wc * 32 + 4 * fq;
#pragma unroll
        for (int ai = 0; ai < 2; ++ai)
#pragma unroll
            for (int m = 0; m < 4; ++m) {
                const int row = row0 + ai * 128 + m * 16;
                const float* rp = mode ? res + (size_t)row * D : (row < MR ? x + (size_t)row * D : (row < MR + NMETA ? meta + (size_t)(row - MR) * D : nullptr));
                float ss = 0.f;
#pragma unroll
                for (int bj = 0; bj < 2; ++bj)
#pragma unroll
                    for (int n = 0; n < 2; ++n) {
                        const int c = col0 + bj * 128 + n * 16;
                        f32x4 r = rp ? *(const f32x4*)(rp + c) : (f32x4){0.f, 0.f, 0.f, 0.f};
                        const f32x4 o = r + acc[ai][bj][m][n] * alpha;
                        *(f32x4*)(out + (size_t)row * D + c) = o;
                        ss += (o.x * o.x + o.y * o.y) + (o.z * o.z + o.w * o.w);
                        if (outb) { u32x2 w; w.x = cvt_pk_bf16(o.x, o.y); w.y = cvt_pk_bf16(o.z, o.w); *(u32x2*)(outb + (size_t)row * D + c) = w; }
                    }
                ss += __shfl_xor(ss, 16); ss += __shfl_xor(ss, 32);
                if (fq == 0) part[(size_t)row * 32 + u.pn * 4 + wc] = ss;
            }
    }
};
struct EpiRec {
    static constexpr bool PERM = true, AFTER_DRAIN = false;
    bf16_t *Q, *Kb, *V, *GS; float *LOGF, *S5U; const float* part; const float* lbp;
    __device__ __forceinline__ void operator()(const f32x4 (&acc)[2][2][4][2], const pg8::Unit& u, int wr, int wc, int fr, int fq) const {
        const int row0 = u.pm * 256 + wr * 64 + fr, colt = u.pn * 256 + wc * 32 + 8 * fq;
        float rs[2][4]; row_rstd(part, row0, fq, rs);
        const int seg = u.pn < 6 ? 0 : (u.pn < 12 ? 1 : (u.pn < 18 ? 2 : (u.pn < 24 ? 3 : 4)));
#pragma unroll
        for (int bj = 0; bj < 2; ++bj) {
            const int c = colt + bj * 128;
            float lb[8];
            if (seg == 1) {
#pragma unroll
                for (int e = 0; e < 8; ++e) { const float a0 = lbp[c - HK + e], a1 = lbp[HK + c - HK + e]; lb[e] = 1.0f / (1.0f + expf(a1 - a0)); }
            }
#pragma unroll
            for (int ai = 0; ai < 2; ++ai)
#pragma unroll
                for (int m = 0; m < 4; ++m) {
                    const size_t row = (size_t)(row0 + ai * 128 + m * 16); const float r = rs[ai][m];
                    float v[8];
#pragma unroll
                    for (int n = 0; n < 2; ++n)
#pragma unroll
                        for (int j = 0; j < 4; ++j) v[n * 4 + j] = acc[ai][bj][m][n][j] * r;
                    if (seg == 0) {
#pragma unroll
                        for (int e = 0; e < 8; ++e) v[e] = fsilu(v[e]) * 0.08838834764831845f;
                        u32x4 w; w.x = cvt_pk_bf16(v[0], v[1]); w.y = cvt_pk_bf16(v[2], v[3]); w.z = cvt_pk_bf16(v[4], v[5]); w.w = cvt_pk_bf16(v[6], v[7]);
                        *(u32x4*)(Q + row * HK + c) = w;
                    } else if (seg == 1) {
                        float kk[8], lf[8];
#pragma unroll
                        for (int e = 0; e < 8; ++e) { const float sg = 1.0f / (1.0f + __expf(-v[e])); const float f = lb[e] + (1.0f - lb[e]) * sg; kk[e] = 1.0f - f; lf[e] = __logf(f); }
                        u32x4 w; w.x = cvt_pk_bf16(kk[0], kk[1]); w.y = cvt_pk_bf16(kk[2], kk[3]); w.z = cvt_pk_bf16(kk[4], kk[5]); w.w = cvt_pk_bf16(kk[6], kk[7]);
                        *(u32x4*)(Kb + row * HK + (c - HK)) = w;
                        *(f32x4*)(LOGF + row * HK + (c - HK)) = (f32x4){lf[0], lf[1], lf[2], lf[3]};
                        *(f32x4*)(LOGF + row * HK + (c - HK) + 4) = (f32x4){lf[4], lf[5], lf[6], lf[7]};
                    } else if (seg == 2) {
                        u32x4 w; w.x = cvt_pk_bf16(v[0], v[1]); w.y = cvt_pk_bf16(v[2], v[3]); w.z = cvt_pk_bf16(v[4], v[5]); w.w = cvt_pk_bf16(v[6], v[7]);
                        *(u32x4*)(V + row * HK + (c - 2 * HK)) = w;
                    } else if (seg == 3) {
#pragma unroll
                        for (int e = 0; e < 8; ++e) v[e] = fsilu(v[e]);
                        u32x4 w; w.x = cvt_pk_bf16(v[0], v[1]); w.y = cvt_pk_bf16(v[2], v[3]); w.z = cvt_pk_bf16(v[4], v[5]); w.w = cvt_pk_bf16(v[6], v[7]);
                        *(u32x4*)(GS + row * HK + (c - 3 * HK)) = w;
                    } else {
                        *(f32x4*)(S5U + row * S5W + (c - 4 * HK)) = (f32x4){v[0], v[1], v[2], v[3]};
                        *(f32x4*)(S5U + row * S5W + (c - 4 * HK) + 4) = (f32x4){v[4], v[5], v[6], v[7]};
                    }
                }
        }
    }
};
struct EpiGates {
    static constexpr bool PERM = true, AFTER_DRAIN = false;
    bf16_t* G; const float* part;
    __device__ __forceinline__ void operator()(const f32x4 (&acc)[2][2][4][2], const pg8::Unit& u, int wr, int wc, int fr, int fq) const {
        const int row0 = u.pm * 256 + wr * 64 + fr, colt = u.pn * 256 + wc * 32 + 8 * fq;
        float rs[2][4]; row_rstd(part, row0, fq, rs);
#pragma unroll
        for (int ai = 0; ai < 2; ++ai)
#pragma unroll
            for (int m = 0; m < 4; ++m) {
                const float r = rs[ai][m];
#pragma unroll
                for (int bj = 0; bj < 2; ++bj) {
                    float v[8];
#pragma unroll
                    for (int n = 0; n < 2; ++n)
#pragma unroll
                        for (int j = 0; j < 4; ++j) v[n * 4 + j] = fsigmoid(acc[ai][bj][m][n][j] * r);
                    u32x4 w; w.x = cvt_pk_bf16(v[0], v[1]); w.y = cvt_pk_bf16(v[2], v[3]); w.z = cvt_pk_bf16(v[4], v[5]); w.w = cvt_pk_bf16(v[6], v[7]);
                    *(u32x4*)(G + (size_t)(row0 + ai * 128 + m * 16) * NGATE + colt + bj * 128) = w;
                }
            }
    }
};
struct EpiGlu {
    static constexpr bool PERM = true, AFTER_DRAIN = false;
    const bf16_t* G; bf16_t* YS;
    __device__ __forceinline__ void operator()(const f32x4 (&acc)[2][2][4][2], const pg8::Unit& u, int wr, int wc, int fr, int fq) const {
        const int row0 = u.pm * 256 + wr * 64 + fr, col0 = u.pn * 128 + wc * 32 + 8 * fq;
#pragma unroll
        for (int ai = 0; ai < 2; ++ai)
#pragma unroll
            for (int m = 0; m < 4; ++m) {
                const size_t row = (size_t)(row0 + ai * 128 + m * 16);
                const u32x4 gw = *(const u32x4*)(G + row * NGATE + D + col0);
                const float g[8] = {bf_lo(gw.x), bf_hi(gw.x), bf_lo(gw.y), bf_hi(gw.y), bf_lo(gw.z), bf_hi(gw.z), bf_lo(gw.w), bf_hi(gw.w)};
                float y[8];
#pragma unroll
                for (int n = 0; n < 2; ++n)
#pragma unroll
                    for (int j = 0; j < 4; ++j) y[n * 4 + j] = g[n * 4 + j] * acc[ai][0][m][n][j] * fsigmoid(acc[ai][1][m][n][j]);
                u32x4 w; w.x = cvt_pk_bf16(y[0], y[1]); w.y = cvt_pk_bf16(y[2], y[3]); w.z = cvt_pk_bf16(y[4], y[5]); w.w = cvt_pk_bf16(y[6], y[7]);
                *(u32x4*)(YS + row * D + col0) = w;
            }
    }
};
struct EpiMerge {
    static constexpr bool PERM = true, AFTER_DRAIN = false;
    const bf16_t* G; const bf16_t* YS; bf16_t* MG;
    __device__ __forceinline__ void operator()(const f32x4 (&acc)[2][2][4][2], const pg8::Unit& u, int wr, int wc, int fr, int fq) const {
        const int row0 = u.pm * 256 + wr * 64 + fr, colt = u.pn * 256 + wc * 32 + 8 * fq;
#pragma unroll
        for (int ai = 0; ai < 2; ++ai)
#pragma unroll
            for (int m = 0; m < 4; ++m) {
                const size_t row = (size_t)(row0 + ai * 128 + m * 16);
#pragma unroll
                for (int bj = 0; bj < 2; ++bj) {
                    const int c = colt + bj * 128;
                    const u32x4 gw = *(const u32x4*)(G + row * NGATE + c), yw = *(const u32x4*)(YS + row * D + c);
                    const float g[8] = {bf_lo(gw.x), bf_hi(gw.x), bf_lo(gw.y), bf_hi(gw.y), bf_lo(gw.z), bf_hi(gw.z), bf_lo(gw.w), bf_hi(gw.w)};
                    const float y[8] = {bf_lo(yw.x), bf_hi(yw.x), bf_lo(yw.y), bf_hi(yw.y), bf_lo(yw.z), bf_hi(yw.z), bf_lo(yw.w), bf_hi(yw.w)};
                    float o[8];
#pragma unroll
                    for (int n = 0; n < 2; ++n)
#pragma unroll
                        for (int j = 0; j < 4; ++j) o[n * 4 + j] = g[n * 4 + j] * acc[ai][bj][m][n][j] + y[n * 4 + j];
                    u32x4 w; w.x = cvt_pk_bf16(o[0], o[1]); w.y = cvt_pk_bf16(o[2], o[3]); w.z = cvt_pk_bf16(o[4], o[5]); w.w = cvt_pk_bf16(o[6], o[7]);
                    *(u32x4*)(MG + row * D + c) = w;
                }
            }
    }
};

__device__ __forceinline__ float wave_sum(float v) {
#pragma unroll
    for (int o = 1; o < 64; o <<= 1) v += __shfl_xor(v, o);
    return v;
}
__device__ __forceinline__ void tr_item(const float* W, int K, int N, bf16_t* WT, const float* gain, int ilv, LAS float* scr, int item, int lane) {
    const int nblk = N / 32, kb = item / nblk, nb = item - kb * nblk, k0 = 64 * kb, n0 = 32 * nb;
    float wv[32];
    const float* wp = W + (size_t)(k0 + (lane >> 5)) * N + n0 + (lane & 31);
#pragma unroll
    for (int i = 0; i < 32; ++i) wv[i] = __builtin_nontemporal_load(wp + (size_t)(2 * i) * N);
    const float gl = gain ? gain[k0 + lane] : 1.0f;
#pragma unroll
    for (int i = 0; i < 32; ++i) { const float g0 = __int_as_float(__builtin_amdgcn_readlane(__float_as_int(gl), 2 * i)), g1 = __int_as_float(__builtin_amdgcn_readlane(__float_as_int(gl), 2 * i + 1)); scr[(2 * i + (lane >> 5)) * 33 + (lane & 31)] = wv[i] * ((lane >> 5) ? g1 : g0); }
    LDS_WAIT();
    const int c = lane & 7;
#pragma unroll
    for (int j = 0; j < 4; ++j) { const int n = (lane >> 3) + 8 * j; const LAS float* s = scr + (8 * c) * 33 + n;
        u32x4 o; o.x = cvt_pk_bf16(s[0 * 33], s[1 * 33]); o.y = cvt_pk_bf16(s[2 * 33], s[3 * 33]); o.z = cvt_pk_bf16(s[4 * 33], s[5 * 33]); o.w = cvt_pk_bf16(s[6 * 33], s[7 * 33]);
        const int nn = n0 + n; const int drow = ilv ? ((nn >> 7) * 256 + (ilv - 1) * 128 + (nn & 127)) : nn;
        *(u32x4*)(WT + (size_t)drow * K + k0 + 8 * c) = o; }
    LDS_WAIT();
}
struct TrJob { const float* W; int K, N; bf16_t* WT; const float* gain; int ilv; };
__device__ __forceinline__ void tr_run(const TrJob& j, int& it, int NGW, LAS float* scr, int lane) {
    const int n = (j.K / 64) * (j.N / 32);
    for (; it < n; it += NGW) tr_item(j.W, j.K, j.N, j.WT, j.gain, j.ilv, scr, it, lane);
    it -= n;
}

__device__ __forceinline__ void skinny_down(LAS unsigned char* lds, int tile, const bf16_t* Hm, const bf16_t* Wd, const float* meta, bf16_t* ABUF, float* PARTB, int wave, int lane) {
    const int lr = lane & 15, lq = lane >> 4, n0 = 16 * tile, kbase = wave * (FF / 8);
    const bf16_t* ap = Hm + (size_t)lr * FF + kbase + 8 * lq; const bf16_t* bp = Wd + (size_t)(n0 + lr) * FF + kbase + 8 * lq;
    f32x4 acc = (f32x4){0.f, 0.f, 0.f, 0.f};
#pragma unroll 11
    for (int s = 0; s < FF / 8 / 32; ++s) { const bf16x8 af = *(const bf16x8*)(ap + 32 * s), bf = *(const bf16x8*)(bp + 32 * s); acc = __builtin_amdgcn_mfma_f32_16x16x32_bf16(bf, af, acc, 0, 0, 0); }
    *(LAS f32x4*)(lds + (wave * 64 + lane) * 16) = acc;
    __syncthreads();
    if (wave == 0) {
        f32x4 t = (f32x4){0.f, 0.f, 0.f, 0.f};
#pragma unroll
        for (int w = 0; w < 8; ++w) t += *(const LAS f32x4*)(lds + (w * 64 + lane) * 16);
        const int col = n0 + 4 * lq; const f32x4 r = *(const f32x4*)(meta + (size_t)lr * D + col); const f32x4 o = r + t * 0.5f;
        u32x2 w2; w2.x = cvt_pk_bf16(o.x, o.y); w2.y = cvt_pk_bf16(o.z, o.w); *(u32x2*)(ABUF + (size_t)(MR + lr) * D + col) = w2;
        float ss = (o.x * o.x + o.y * o.y) + (o.z * o.z + o.w * o.w); ss += __shfl_xor(ss, 16); ss += __shfl_xor(ss, 32);
        if (lq == 0) atomicAdd(PARTB + (size_t)(MR + lr) * 32 + (tile & 31), ss);
    }
    __syncthreads();
}

constexpr int HG_A1 = 0, HG_A2 = 17408, HG_BK = 34816, HG_ST = 52224, HG_VT = 87040, HG_P = 105472, HG_SSQ = 114688;
constexpr int HL_KT = 0, HL_VT = 18432, HL_QT = 36864;
__device__ __forceinline__ void hg_local_item(LAS unsigned char* lds, int item, float* LOGF, const bf16_t* Kb, const bf16_t* Vb, bf16_t* ST, float* DEC, int tid, int wave, int lane) {
    const int c = item / NH, h = item - c * NH;
    const int row0 = c == 0 ? MR : 64 * (c - 1), T = c == 0 ? NMETA : 64;
    const int kcol = tid & 127, tq = tid >> 7;
    float* LF = LOGF + (size_t)row0 * HK + h * 128 + kcol;
    LAS float* qt = (LAS float*)(lds + HL_QT);
    float cs[16]; float run = 0.f;
#pragma unroll
    for (int i = 0; i < 16; ++i) { const int t = tq * 16 + i; const float v = (t < T) ? LF[(size_t)t * HK] : 0.f; run += v; cs[i] = run; }
    qt[tq * 128 + kcol] = run;
    __syncthreads();
    float pre = 0.f, tot = 0.f;
#pragma unroll
    for (int q = 0; q < 4; ++q) { const float x = qt[q * 128 + kcol]; tot += x; if (q < tq) pre += x; }
#pragma unroll
    for (int i = 0; i < 16; ++i) { const int t = tq * 16 + i; cs[i] += pre; if (t < T) LF[(size_t)t * HK] = cs[i]; }
    if (c == NCH - 1) { __syncthreads(); return; }
    {
        const bf16_t* KP = Kb + (size_t)row0 * HK + h * 128 + kcol; const bf16_t* VP = Vb + (size_t)row0 * HK + h * 128 + kcol;
        float kd[16]; unsigned vv[16];
#pragma unroll
        for (int i = 0; i < 16; ++i) { const int t = tq * 16 + i; const bool ok = t < T;
            kd[i] = ok ? bf2f(KP[(size_t)t * HK]) * __expf(tot - cs[i]) : 0.f; vv[i] = ok ? (unsigned)VP[(size_t)t * HK] : 0u; }
        u32x4 a, b;
        a.x = cvt_pk_bf16(kd[0], kd[1]); a.y = cvt_pk_bf16(kd[2], kd[3]); a.z = cvt_pk_bf16(kd[4], kd[5]); a.w = cvt_pk_bf16(kd[6], kd[7]);
        b.x = cvt_pk_bf16(kd[8], kd[9]); b.y = cvt_pk_bf16(kd[10], kd[11]); b.z = cvt_pk_bf16(kd[12], kd[13]); b.w = cvt_pk_bf16(kd[14], kd[15]);
        *(LAS u32x4*)(lds + HL_KT + kcol * 144 + tq * 32) = a; *(LAS u32x4*)(lds + HL_KT + kcol * 144 + tq * 32 + 16) = b;
        a.x = vv[0] | (vv[1] << 16); a.y = vv[2] | (vv[3] << 16); a.z = vv[4] | (vv[5] << 16); a.w = vv[6] | (vv[7] << 16);
        b.x = vv[8] | (vv[9] << 16); b.y = vv[10] | (vv[11] << 16); b.z = vv[12] | (vv[13] << 16); b.w = vv[14] | (vv[15] << 16);
        *(LAS u32x4*)(lds + HL_VT + kcol * 144 + tq * 32) = a; *(LAS u32x4*)(lds + HL_VT + kcol * 144 + tq * 32 + 16) = b;
        if (tq == 0) DEC[(size_t)(c * NH + h) * 128 + kcol] = __expf(tot);
    }
    __syncthreads();
    {
        const int vt0 = (wave >> 1) * 2, kt0 = (wave & 1) * 4, lr = lane & 15, lq = lane >> 4;
        f32x4 acc[2][4];
#pragma unroll
        for (int a = 0; a < 2; ++a)
#pragma unroll
            for (int b = 0; b < 4; ++b) acc[a][b] = (f32x4){0.f, 0.f, 0.f, 0.f};
#pragma unroll
        for (int ks = 0; ks < 2; ++ks) {
            bf16x8 vf[2], kf[4];
#pragma unroll
            for (int a = 0; a < 2; ++a) vf[a] = *(const LAS bf16x8*)(lds + HL_VT + (16 * (vt0 + a) + lr) * 144 + (ks * 32 + 8 * lq) * 2);
#pragma unroll
            for (int b = 0; b < 4; ++b) kf[b] = *(const LAS bf16x8*)(lds + HL_KT + (16 * (kt0 + b) + lr) * 144 + (ks * 32 + 8 * lq) * 2);
#pragma unroll
            for (int a = 0; a < 2; ++a)
#pragma unroll
                for (int b = 0; b < 4; ++b) acc[a][b] = __builtin_amdgcn_mfma_f32_16x16x32_bf16(kf[b], vf[a], acc[a][b], 0, 0, 0);
        }
        bf16_t* dst = ST + (size_t)(c * NH + h) * 16384;
#pragma unroll
        for (int a = 0; a < 2; ++a)
#pragma unroll
            for (int b = 0; b < 4; ++b) { const int v = 16 * (vt0 + a) + lr, k = 16 * (kt0 + b) + 4 * lq;
                u32x2 w; w.x = cvt_pk_bf16(acc[a][b].x, acc[a][b].y); w.y = cvt_pk_bf16(acc[a][b].z, acc[a][b].w);
                *(u32x2*)(dst + v * 128 + k) = w; }
    }
    __syncthreads();
}
__device__ __forceinline__ void hg_out_item(LAS unsigned char* lds, int item, const float* B, const bf16_t* Q, const bf16_t* Kb, const bf16_t* Vb, const bf16_t* ST, bf16_t* GS, const float* hg_norm, int tid, int wave, int lane) {
    const int c = 1 + item / NH, h = item % NH, row0 = 64 * (c - 1);
#pragma unroll
    for (int jj = 0; jj < 2; ++jj) {
        const int p = tid + 512 * jj, t = p >> 4, k0 = 8 * (p & 15);
        const size_t off = (size_t)(row0 + t) * HK + h * 128 + k0, roff = (size_t)(row0 + 31) * HK + h * 128 + k0;
        const f32x4 b0 = *(const f32x4*)(B + off), b1 = *(const f32x4*)(B + off + 4), r0 = *(const f32x4*)(B + roff), r1 = *(const f32x4*)(B + roff + 4);
        const u32x4 qw = *(const u32x4*)(Q + off), kw = *(const u32x4*)(Kb + off);
        const float bb[8] = {b0.x, b0.y, b0.z, b0.w, b1.x, b1.y, b1.z, b1.w}, rr[8] = {r0.x, r0.y, r0.z, r0.w, r1.x, r1.y, r1.z, r1.w};
        const float qq[8] = {bf_lo(qw.x), bf_hi(qw.x), bf_lo(qw.y), bf_hi(qw.y), bf_lo(qw.z), bf_hi(qw.z), bf_lo(qw.w), bf_hi(qw.w)};
        const float kk[8] = {bf_lo(kw.x), bf_hi(kw.x), bf_lo(kw.y), bf_hi(kw.y), bf_lo(kw.z), bf_hi(kw.z), bf_lo(kw.w), bf_hi(kw.w)};
        float a1[8], a2[8], bk[8];
#pragma unroll
        for (int e = 0; e < 8; ++e) { a1[e] = qq[e] * __expf(bb[e]); a2[e] = qq[e] * __expf(bb[e] - rr[e]); bk[e] = kk[e] * __expf(rr[e] - bb[e]); }
        u32x4 w;
        w.x = cvt_pk_bf16(a1[0], a1[1]); w.y = cvt_pk_bf16(a1[2], a1[3]); w.z = cvt_pk_bf16(a1[4], a1[5]); w.w = cvt_pk_bf16(a1[6], a1[7]); *(LAS u32x4*)(lds + HG_A1 + t * 272 + k0 * 2) = w;
        w.x = cvt_pk_bf16(a2[0], a2[1]); w.y = cvt_pk_bf16(a2[2], a2[3]); w.z = cvt_pk_bf16(a2[4], a2[5]); w.w = cvt_pk_bf16(a2[6], a2[7]); *(LAS u32x4*)(lds + HG_A2 + t * 272 + k0 * 2) = w;
        w.x = cvt_pk_bf16(bk[0], bk[1]); w.y = cvt_pk_bf16(bk[2], bk[3]); w.z = cvt_pk_bf16(bk[4], bk[5]); w.w = cvt_pk_bf16(bk[6], bk[7]); *(LAS u32x4*)(lds + HG_BK + t * 272 + k0 * 2) = w;
    }
    {
        const int vcol = tid & 127, tq = tid >> 7; const bf16_t* VP = Vb + (size_t)(row0 + tq * 16) * HK + h * 128 + vcol; unsigned vv[16];
#pragma unroll
        for (int i = 0; i < 16; ++i) vv[i] = (unsigned)VP[(size_t)i * HK];
        u32x4 a, b;
        a.x = vv[0] | (vv[1] << 16); a.y = vv[2] | (vv[3] << 16); a.z = vv[4] | (vv[5] << 16); a.w = vv[6] | (vv[7] << 16);
        b.x = vv[8] | (vv[9] << 16); b.y = vv[10] | (vv[11] << 16); b.z = vv[12] | (vv[13] << 16); b.w = vv[14] | (vv[15] << 16);
        *(LAS u32x4*)(lds + HG_VT + vcol * 144 + tq * 32) = a; *(LAS u32x4*)(lds + HG_VT + vcol * 144 + tq * 32 + 16) = b;
    }
    {
        const u32x4* src = (const u32x4*)(ST + (size_t)(c * NH + h) * 16384);
#pragma unroll
        for (int jj = 0; jj < 4; ++jj) { const int idx = tid + 512 * jj; *(LAS u32x4*)(lds + HG_ST + (idx >> 4) * 272 + (idx & 15) * 16) = src[idx]; }
    }
    __syncthreads();
    const int lr = lane & 15, lq = lane >> 4;
    {
        const int tt = wave >> 1;
#pragma unroll
        for (int sh = 0; sh < 2; ++sh) {
            const int ss = 2 * (wave & 1) + sh;
            f32x4 acc = (f32x4){0.f, 0.f, 0.f, 0.f};
            if (ss <= tt) {
#pragma unroll
                for (int ks = 0; ks < 4; ++ks) {
                    const bf16x8 af = *(const LAS bf16x8*)(lds + HG_A2 + (16 * tt + lr) * 272 + (ks * 32 + 8 * lq) * 2);
                    const bf16x8 bf = *(const LAS bf16x8*)(lds + HG_BK + (16 * ss + lr) * 272 + (ks * 32 + 8 * lq) * 2);
                    acc = __builtin_amdgcn_mfma_f32_16x16x32_bf16(bf, af, acc, 0, 0, 0);
                }
            }
            const int t = 16 * tt + lr, s0 = 16 * ss + 4 * lq;
            float pv[4];
#pragma unroll
            for (int r = 0; r < 4; ++r) pv[r] = (s0 + r <= t) ? acc[r] : 0.f;
            u32x2 w; w.x = cvt_pk_bf16(pv[0], pv[1]); w.y = cvt_pk_bf16(pv[2], pv[3]);
            *(LAS u32x2*)(lds + HG_P + t * 144 + s0 * 2) = w;
        }
    }
    __syncthreads();
    f32x4 acc[4];
#pragma unroll
    for (int tt = 0; tt < 4; ++tt) acc[tt] = (f32x4){0.f, 0.f, 0.f, 0.f};
#pragma unroll
    for (int ks = 0; ks < 4; ++ks) {
        const bf16x8 sf = *(const LAS bf16x8*)(lds + HG_ST + (16 * wave + lr) * 272 + (ks * 32 + 8 * lq) * 2);
#pragma unroll
        for (int tt = 0; tt < 4; ++tt) { const bf16x8 af = *(const LAS bf16x8*)(lds + HG_A1 + (16 * tt + lr) * 272 + (ks * 32 + 8 * lq) * 2);
            acc[tt] = __builtin_amdgcn_mfma_f32_16x16x32_bf16(sf, af, acc[tt], 0, 0, 0); }
    }
#pragma unroll
    for (int ks = 0; ks < 2; ++ks) {
        const bf16x8 vf = *(const LAS bf16x8*)(lds + HG_VT + (16 * wave + lr) * 144 + (ks * 32 + 8 * lq) * 2);
#pragma unroll
        for (int tt = 0; tt < 4; ++tt) { const bf16x8 pf = *(const LAS bf16x8*)(lds + HG_P + (16 * tt + lr) * 144 + (ks * 32 + 8 * lq) * 2);
            acc[tt] = __builtin_amdgcn_mfma_f32_16x16x32_bf16(vf, pf, acc[tt], 0, 0, 0); }
    }
    LAS float* ssq = (LAS float*)(lds + HG_SSQ);
#pragma unroll
    for (int tt = 0; tt < 4; ++tt) { float s = (acc[tt].x * acc[tt].x + acc[tt].y * acc[tt].y) + (acc[tt].z * acc[tt].z + acc[tt].w * acc[tt].w);
        s += __shfl_xor(s, 16); s += __shfl_xor(s, 32); if (lq == 0) ssq[wave * 64 + 16 * tt + lr] = s; }
    __syncthreads();
    {
        const int col = h * 128 + 16 * wave + 4 * lq; const f32x4 hn = *(const f32x4*)(hg_norm + col);
#pragma unroll
        for (int tt = 0; tt < 4; ++tt) { const int t = 16 * tt + lr; float tot = 0.f;
#pragma unroll
            for (int w8 = 0; w8 < 8; ++w8) tot += ssq[w8 * 64 + t];
            const float rinv = rsqrtf(tot * (1.0f / 128.0f) + EPS);
            bf16_t* gp = GS + (size_t)(row0 + t) * HK + col; const u32x2 gw = *(const u32x2*)gp;
            u32x2 w; w.x = cvt_pk_bf16(acc[tt].x * rinv * hn.x * bf_lo(gw.x), acc[tt].y * rinv * hn.y * bf_hi(gw.x));
            w.y = cvt_pk_bf16(acc[tt].z * rinv * hn.z * bf_lo(gw.y), acc[tt].w * rinv * hn.w * bf_hi(gw.y));
            *(u32x2*)gp = w; }
    }
    __syncthreads();
}

__device__ __forceinline__ void sincos_d(double x, double& s, double& c) {
    const double kq = rint(x * 0.63661977236758134308);
    double r = fma(-kq, 1.57079632679489655800, x); r = fma(-kq, 6.12323399573676603587e-17, r);
    const double r2 = r * r;
    double sp = 1.0 / 6227020800.0; sp = fma(sp, r2, -1.0 / 39916800.0); sp = fma(sp, r2, 1.0 / 362880.0); sp = fma(sp, r2, -1.0 / 5040.0); sp = fma(sp, r2, 1.0 / 120.0); sp = fma(sp, r2, -1.0 / 6.0); sp = fma(sp * r2, r, r);
    double cp = -1.0 / 87178291200.0; cp = fma(cp, r2, 1.0 / 479001600.0); cp = fma(cp, r2, -1.0 / 3628800.0); cp = fma(cp, r2, 1.0 / 40320.0); cp = fma(cp, r2, -1.0 / 720.0); cp = fma(cp, r2, 1.0 / 24.0); cp = fma(cp, r2, -0.5); cp = fma(cp, r2, 1.0);
    const int q = ((int)kq) & 3;
    s = (q == 0) ? sp : (q == 1) ? cp : (q == 2) ? -sp : -cp;
    c = (q == 0) ? cp : (q == 1) ? -sp : (q == 2) ? -cp : sp;
}
struct S5In { const float *lam_re, *lam_im, *log_step, *b_re, *b_im, *c_re, *c_im, *d; };
__device__ __forceinline__ void s5_abar(const S5In& P, int g, int n, float& are, float& aim, float& cr, float& ci) {
    const float lr = P.lam_re[g * NS + n], li = P.lam_im[g * NS + n], dt = expf(P.log_step[g]);
    const float mag = expf(lr * dt); double s, c; sincos_d((double)li * (double)dt, s, c);
    const double ar = (double)mag * c, ai = (double)mag * s;
    are = (float)ar; aim = (float)ai;
    const double nr = ar - 1.0, ni = ai, den = (double)lr * lr + (double)li * li;
    cr = (float)((nr * lr + ni * li) / den); ci = (float)((ni * lr - nr * li) / den);
}
__device__ __forceinline__ void s5_setup(const S5In& P, int g, int lane, float& are, float& aim, float (&bbr)[16], float (&bbi)[16]) {
    float cr, ci; s5_abar(P, g, lane, are, aim, cr, ci);
    const f32x4* br = (const f32x4*)(P.b_re + (size_t)(g * NS + lane) * 16); const f32x4* bi = (const f32x4*)(P.b_im + (size_t)(g * NS + lane) * 16);
#pragma unroll
    for (int q = 0; q < 4; ++q) { const f32x4 r = br[q], i = bi[q];
#pragma unroll
        for (int e = 0; e < 4; ++e) { bbr[q * 4 + e] = cr * r[e] - ci * i[e]; bbi[q * 4 + e] = cr * i[e] + ci * r[e]; } }
}
#define S5_STEP4(uv)                                                                                                     \
    _Pragma("unroll") for (int j = 0; j < 4; ++j) {                                                                      \
        float bur = 0.f, bui = 0.f;                                                                                      \
        _Pragma("unroll") for (int p = 0; p < 16; ++p) { const float up = __int_as_float(__builtin_amdgcn_readlane(__float_as_int(uv), j * 16 + p)); bur = fmaf(up, bbr[p], bur); bui = fmaf(up, bbi[p], bui); } \
        const float nxr = are * xr - aim * xi + bur; xi = are * xi + aim * xr + bui; xr = nxr;                           \
        S5_EMIT(j) }
__device__ __forceinline__ void s5_local_item(const S5In& P, int item, const float* S5U, float* S5E, int lane) {
    const int c = item >> 5, g = item & 31; const int row0 = c == 0 ? MR : 64 * (c - 1), T = c == 0 ? NMETA : 64;
    float are, aim, bbr[16], bbi[16]; s5_setup(P, g, lane, are, aim, bbr, bbi);
    float xr = 0.f, xi = 0.f;
#define S5_EMIT(j)
    for (int tb = 0; tb < T; tb += 4) { const float uv = S5U[(size_t)(row0 + tb + (lane >> 4)) * S5W + g * 16 + (lane & 15)]; S5_STEP4(uv) }
#undef S5_EMIT
    *(float2*)(S5E + ((size_t)c * 2048 + g * NS + lane) * 2) = make_float2(xr, xi);
}
__device__ __forceinline__ float gelu_tanh(float x) { const float u = 0.7978845608028654f * (x + 0.044715f * x * x * x); const float th = 1.0f - 2.0f * __builtin_amdgcn_rcpf(1.0f + __expf(2.0f * u)); return 0.5f * x * (1.0f + th); }
__device__ __forceinline__ void s5_out_item(LAS unsigned char* xs, const S5In& P, int item, const float* S5U, const float* S5E, bf16_t* Z, int lane) {
    const int c = 1 + (item >> 5), g = item & 31, row0 = 64 * (c - 1), lr = lane & 15, lq = lane >> 4;
    float are, aim, bbr[16], bbi[16]; s5_setup(P, g, lane, are, aim, bbr, bbi);
    bf16x8 cf[4];
#pragma unroll
    for (int ks = 0; ks < 4; ++ks) { const float* src = (ks < 2 ? P.c_re : P.c_im) + (size_t)(g * 16 + lr) * NS + (ks & 1) * 32 + 8 * lq; const float sg = ks < 2 ? 1.f : -1.f;
        const f32x4 a = *(const f32x4*)src, b = *(const f32x4*)(src + 4);
        u32x4 w; w.x = cvt_pk_bf16(sg * a.x, sg * a.y); w.y = cvt_pk_bf16(sg * a.z, sg * a.w); w.z = cvt_pk_bf16(sg * b.x, sg * b.y); w.w = cvt_pk_bf16(sg * b.z, sg * b.w);
        cf[ks] = __builtin_bit_cast(bf16x8, w); }
    const f32x4 dk = *(const f32x4*)(P.d + g * 16 + 4 * lq);
    const float2 x0 = *(const float2*)(S5E + ((size_t)c * 2048 + g * NS + lane) * 2);
    float xr = x0.x, xi = x0.y;
    for (int blk = 0; blk < 4; ++blk) {
#define S5_EMIT(j) { const unsigned pk = cvt_pk_bf16(xr, xi); *(LAS bf16_t*)(xs + (sub * 4 + j) * 272 + lane * 2) = (bf16_t)(pk & 0xffffu); *(LAS bf16_t*)(xs + (sub * 4 + j) * 272 + 128 + lane * 2) = (bf16_t)(pk >> 16); }
#pragma unroll
        for (int sub = 0; sub < 4; ++sub) { const float uv = S5U[(size_t)(row0 + blk * 16 + sub * 4 + (lane >> 4)) * S5W + g * 16 + (lane & 15)]; S5_STEP4(uv) }
#undef S5_EMIT
        LDS_WAIT(); __builtin_amdgcn_wave_barrier();
        f32x4 acc = (f32x4){0.f, 0.f, 0.f, 0.f};
#pragma unroll
        for (int ks = 0; ks < 4; ++ks) { const bf16x8 xf = *(const LAS bf16x8*)(xs + lr * 272 + (ks * 32 + 8 * lq) * 2); acc = __builtin_amdgcn_mfma_f32_16x16x32_bf16(cf[ks], xf, acc, 0, 0, 0); }
        const size_t row = (size_t)(row0 + blk * 16 + lr);
        const f32x4 u4 = *(const f32x4*)(S5U + row * S5W + g * 16 + 4 * lq);
        u32x2 w; w.x = cvt_pk_bf16(gelu_tanh(acc.x + dk.x * u4.x), gelu_tanh(acc.y + dk.y * u4.y)); w.y = cvt_pk_bf16(gelu_tanh(acc.z + dk.z * u4.z), gelu_tanh(acc.w + dk.w * u4.w));
        *(u32x2*)(Z + row * S5W + g * 16 + 4 * lq) = w;
        LDS_WAIT(); __builtin_amdgcn_wave_barrier();
    }
}

__global__ void __launch_bounds__(512, 2) fwd(Args a) {
    __shared__ __attribute__((aligned(16))) unsigned char lds_raw[LDS_BYTES];
    LAS unsigned char* lds = (LAS unsigned char*)lds_raw;
    const int tid = threadIdx.x, lane = tid & 63, wave = __builtin_amdgcn_readfirstlane(tid >> 6);
    const int G = gridDim.x, bx = blockIdx.x, gw = bx * 8 + wave, NGW = G * 8;
    unsigned char* ws = a.ws;
    const float* x = a.in[0]; const float* meta = a.in[1];
    bf16_t* WGU = (bf16_t*)(ws + WS_WGU); bf16_t* WD = (bf16_t*)(ws + WS_WD); bf16_t* WIN = (bf16_t*)(ws + WS_WIN); bf16_t* WHG = (bf16_t*)(ws + WS_WHG);
    bf16_t* WGLU = (bf16_t*)(ws + WS_WGLU); bf16_t* WOUT = (bf16_t*)(ws + WS_WOUT);
    float* HRES = (float*)(ws + WS_HRES); bf16_t* ABUF = (bf16_t*)(ws + WS_ABUF);
    bf16_t* Qb = (bf16_t*)(ws + WS_Q); bf16_t* Kb = (bf16_t*)(ws + WS_K); float* LOGF = (float*)(ws + WS_LOGF); bf16_t* Vb = (bf16_t*)(ws + WS_V); bf16_t* GS = (bf16_t*)(ws + WS_GS);
    float* S5U = (float*)(ws + WS_S5U); bf16_t* Z = (bf16_t*)(ws + WS_Z); float* PARTA = (float*)(ws + WS_PARTA); float* PARTB = (float*)(ws + WS_PARTB);
    float* DEC = (float*)(ws + WS_DEC); float* S5E = (float*)(ws + WS_S5E); bf16_t* Hh = (bf16_t*)(ws + WS_H); bf16_t* GATES = (bf16_t*)(ws + WS_GATES);
    bf16_t* ST = (bf16_t*)a.out; bf16_t* YS = (bf16_t*)((unsigned char*)a.out + DO_YS); bf16_t* MERGED = (bf16_t*)((unsigned char*)a.out + DO_MERGED);
    S5In s5p{a.in[11], a.in[12], a.in[13], a.in[14], a.in[15], a.in[16], a.in[17], a.in[18]};
    const int lo = a.lo, hi = a.hi;
    cg::grid_group grid = cg::this_grid();
#define IN(k) (lo <= (k) && (k) < hi)
#define SEAM(k) do { if (IN((k) + 1)) grid.sync(); } while (0)
    LAS float* scr = (LAS float*)(lds + wave * 8448);

    if (IN(0)) {
        int it = gw;
        tr_run(TrJob{a.in[3], D, FF, WGU, a.in[2], 1}, it, NGW, scr, lane);
        tr_run(TrJob{a.in[4], D, FF, WGU, a.in[2], 2}, it, NGW, scr, lane);
        tr_run(TrJob{a.in[5], FF, D, WD, nullptr, 0}, it, NGW, scr, lane);
        tr_run(TrJob{a.in[7], D, INCOLS, WIN, a.in[6], 0}, it, NGW, scr, lane);
        tr_run(TrJob{a.in[10], HK, D, WHG, nullptr, 0}, it, NGW, scr, lane);
        tr_run(TrJob{a.in[19], S5W, D, WGLU, nullptr, 1}, it, NGW, scr, lane);
        tr_run(TrJob{a.in[20], S5W, D, WGLU, nullptr, 2}, it, NGW, scr, lane);
        tr_run(TrJob{a.in[21], D, D, WOUT, nullptr, 0}, it, NGW, scr, lane);
        for (int row = gw; row < MP; row += NGW) {
            const float* src = row < MR ? x + (size_t)row * D : (row < MR + NMETA ? meta + (size_t)(row - MR) * D : nullptr);
            float ss = 0.f;
#pragma unroll
            for (int j = 0; j < 8; ++j) { const f32x4 v = src ? *(const f32x4*)(src + 4 * lane + 256 * j) : (f32x4){0.f, 0.f, 0.f, 0.f};
                ss += (v.x * v.x + v.y * v.y) + (v.z * v.z + v.w * v.w);
                u32x2 w; w.x = cvt_pk_bf16(v.x, v.y); w.y = cvt_pk_bf16(v.z, v.w); *(u32x2*)(ABUF + (size_t)row * D + 4 * lane + 256 * j) = w; }
            ss = wave_sum(ss);
            if (lane < 32) { PARTA[(size_t)row * 32 + lane] = lane == 0 ? ss : 0.f; if (row >= MR) PARTB[(size_t)row * 32 + lane] = 0.f; }
        }
        SEAM(0);
    }
    if (IN(1)) { pg8::Gemm g{ABUF, WGU, MP, 2 * FF, D}; pg8::StaticOrder S; S.init(MP, 2 * FF, G, bx); EpiSwiglu E{Hh, PARTA}; pg8::gemm_phase(lds, g, S, E); SEAM(1); }
    if (IN(2)) { if (bx < D / 16) skinny_down(lds, bx, Hh + (size_t)MR * FF, WD, meta, ABUF, PARTB, wave, lane);
        pg8::Gemm g{Hh, WD, MR, D, FF}; pg8::StaticOrder S; S.init(MR, D, G, bx); EpiRes E{nullptr, x, meta, HRES, ABUF, PARTB, 0.5f, 0}; pg8::gemm_phase(lds, g, S, E); SEAM(2); }
    if (IN(3)) { pg8::Gemm g{ABUF, WIN, MP, NREC, D}; pg8::StaticOrder S; S.init(MP, NREC, G, bx); EpiRec E{Qb, Kb, Vb, GS, LOGF, S5U, PARTB, a.in[8]}; pg8::gemm_phase(lds, g, S, E); SEAM(3); }
    if (IN(4)) {
#ifndef DBG_NO_HGL
        for (int item = bx; item < NCH * NH; item += G) hg_local_item(lds, item, LOGF, Kb, Vb, ST, DEC, tid, wave, lane);
#endif
#ifndef DBG_NO_S5L
        for (int item = gw; item < 128 * 32; item += NGW) s5_local_item(s5p, item, S5U, S5E, lane);
#endif
        SEAM(4);
    }
    if (IN(5)) {
        const int gt = bx * 512 + tid;
        if (gt < 98304) {
            unsigned* S32 = (unsigned*)ST; const int e = gt, h = e >> 13, k = (e & 63) * 2;
            float s0 = 0.f, s1 = 0.f;
            for (int cb = 0; cb < 128; cb += 8) {
                unsigned w[8]; float2 d[8];
#pragma unroll
                for (int j = 0; j < 8; ++j) { w[j] = S32[(size_t)(cb + j) * 98304 + e]; d[j] = *(const float2*)(DEC + (size_t)((cb + j) * NH + h) * 128 + k); }
#pragma unroll
                for (int j = 0; j < 8; ++j) { S32[(size_t)(cb + j) * 98304 + e] = cvt_pk_bf16(s0, s1); s0 = fmaf(d[j].x, s0, bf_lo(w[j])); s1 = fmaf(d[j].y, s1, bf_hi(w[j])); }
            }
            S32[(size_t)128 * 98304 + e] = cvt_pk_bf16(s0, s1);
        } else if (gt < 98304 + 2048) {
            const int ch = gt - 98304; float ar, ai, cr, ci; s5_abar(s5p, ch >> 6, ch & 63, ar, ai, cr, ci);
#pragma unroll
            for (int q = 0; q < 6; ++q) { const float nr = ar * ar - ai * ai; ai = 2.f * ar * ai; ar = nr; }
            float xr = 0.f, xi = 0.f;
            for (int c = 0; c < 128; ++c) { float2* p = (float2*)(S5E + ((size_t)c * 2048 + ch) * 2); const float2 ev = *p; *p = make_float2(xr, xi);
                const float nxr = ar * xr - ai * xi + ev.x; xi = ar * xi + ai * xr + ev.y; xr = nxr; }
            *(float2*)(S5E + ((size_t)128 * 2048 + ch) * 2) = make_float2(xr, xi);
        }
        int it = gw;
        tr_run(TrJob{a.in[23], D, FF, WGU, a.in[22], 1}, it, NGW, scr, lane);
        tr_run(TrJob{a.in[24], D, FF, WGU, a.in[22], 2}, it, NGW, scr, lane);
        tr_run(TrJob{a.in[25], FF, D, WD, nullptr, 0}, it, NGW, scr, lane);
        SEAM(5);
    }
    if (IN(6)) {
        for (int item = bx; item < 128 * NH; item += G) hg_out_item(lds, item, LOGF, Qb, Kb, Vb, ST, GS, a.in[9], tid, wave, lane);
        for (int item = gw; item < 128 * 32; item += NGW) s5_out_item(lds + wave * 4352, s5p, item, S5U, S5E, Z, lane);
        SEAM(6);
    }
    if (IN(7)) { pg8::Gemm g{ABUF, WIN + (size_t)NREC * D, MR, NGATE, D}; pg8::StaticOrder S; S.init(MR, NGATE, G, bx); EpiGates E{GATES, PARTB}; pg8::gemm_phase(lds, g, S, E); SEAM(7); }
    if (IN(8)) { pg8::Gemm g{Z, WGLU, MR, 2 * D, S5W}; pg8::StaticOrder S; S.init(MR, 2 * D, G, bx); EpiGlu E{GATES, YS}; pg8::gemm_phase(lds, g, S, E); SEAM(8); }
    if (IN(9)) { pg8::Gemm g{GS, WHG, MR, D, HK}; pg8::StaticOrder S; S.init(MR, D, G, bx); EpiMerge E{GATES, YS, MERGED}; pg8::gemm_phase(lds, g, S, E); SEAM(9); }
    if (IN(10)) { pg8::Gemm g{MERGED, WOUT, MR, D, D}; pg8::StaticOrder S; S.init(MR, D, G, bx); EpiRes E{HRES, x, meta, HRES, ABUF, PARTA, 1.0f, 1}; pg8::gemm_phase(lds, g, S, E); SEAM(10); }
    if (IN(11)) { pg8::Gemm g{ABUF, WGU, MR, 2 * FF, D}; pg8::StaticOrder S; S.init(MR, 2 * FF, G, bx); EpiSwiglu E{Hh, PARTA}; pg8::gemm_phase(lds, g, S, E); SEAM(11); }
    if (IN(12)) { pg8::Gemm g{Hh, WD, MR, D, FF}; pg8::StaticOrder S; S.init(MR, D, G, bx); EpiRes E{HRES, x, meta, a.out, nullptr, PARTB, 0.5f, 1}; pg8::gemm_phase(lds, g, S, E); SEAM(12); }
    if (IN(13)) {
        const float* gf = a.in[26];
        for (int row = gw; row < MR; row += NGW) {
            const float pv = lane < 32 ? PARTB[(size_t)row * 32 + lane] : 0.f; const float rstd = rsqrtf(wave_sum(pv) * (1.0f / D) + EPS);
            float* o = a.out + (size_t)row * D;
#pragma unroll
            for (int j = 0; j < 8; ++j) { f32x4 v = *(f32x4*)(o + 4 * lane + 256 * j); const f32x4 gg = *(const f32x4*)(gf + 4 * lane + 256 * j);
                v.x *= rstd * gg.x; v.y *= rstd * gg.y; v.z *= rstd * gg.z; v.w *= rstd * gg.w; *(f32x4*)(o + 4 * lane + 256 * j) = v; }
        }
    }
#undef IN
#undef SEAM
}


#ifdef DBG_STOP
struct DbgReg { const unsigned* p; size_t nwords; };
struct DbgArgs { DbgReg r[24]; int n; int pad; unsigned* sums; };
__global__ void dbg_sum(DbgArgs d) {
    for (int i = 0; i < d.n; ++i) { unsigned s = 0; for (size_t w = (size_t)blockIdx.x * blockDim.x + threadIdx.x; w < d.r[i].nwords; w += (size_t)gridDim.x * blockDim.x) s += d.r[i].p[w] * 2654435761u + (unsigned)w;
        for (int o = 1; o < 64; o <<= 1) s += __shfl_xor(s, o);
        if ((threadIdx.x & 63) == 0) atomicAdd(d.sums + i, s); }
}
__global__ void dbg_fill(float* out, const unsigned* sums, int n, size_t total) {
    for (size_t w = (size_t)blockIdx.x * blockDim.x + threadIdx.x; w < total; w += (size_t)gridDim.x * blockDim.x) out[w] = w < (size_t)n ? (float)(sums[w] & 0xFFFFFu) : 0.f;
}
#endif
constexpr int NPHASES = 14;
extern "C" void kernel_launch(void* const* d_in, const int* in_sizes, int n_in, void* d_out, int out_size, void* d_ws, size_t ws_size, hipStream_t stream) {
    static int grid = 0;
    if (grid == 0) {
        if (n_in != 27 || out_size != MR * D || ws_size < WS_END + 256) { fprintf(stderr, "kernel_launch: unexpected shapes (n_in %d out %d ws %zu need %zu)\n", n_in, out_size, ws_size, (size_t)WS_END); grid = -1; return; }
        int dev = 0, cus = 0, per_cu = 0;
        (void)hipGetDevice(&dev); (void)hipDeviceGetAttribute(&cus, hipDeviceAttributeMultiprocessorCount, dev);
        if (hipOccupancyMaxActiveBlocksPerMultiprocessor(&per_cu, (const void*)fwd, 512, 0) != hipSuccess || per_cu < 1) { fprintf(stderr, "kernel_launch: occupancy query gave %d\n", per_cu); per_cu = 1; }
        (void)hipGetLastError();
        grid = cus * 1;
        fprintf(stderr, "kernel_launch: grid %d (cus %d, per_cu %d), ws %zu need %zu\n", grid, cus, per_cu, ws_size, (size_t)WS_END);
    }
    if (grid < 0) return;
    Args a{};
    for (int i = 0; i < 27; ++i) a.in[i] = (const float*)d_in[i];
    a.out = (float*)d_out; a.ws = (unsigned char*)d_ws;
#if MK_MULTI
#ifdef DBG_STOP
    for (int p = 0; p <= DBG_STOP; ++p) { a.lo = p; a.hi = p + 1; hipLaunchKernelGGL(fwd, dim3(grid), dim3(512), 0, stream, a); }
    {
        unsigned char* ws = (unsigned char*)d_ws; DbgArgs d{}; int n = 0;
        auto add = [&](size_t off, size_t bytes) { d.r[n].p = (const unsigned*)(ws + off); d.r[n].nwords = bytes / 4; ++n; };
        const int sel = DBG_SEL;
        if (sel & 1) { add(WS_WGU, (size_t)2 * FF * D * 2); add(WS_WD, (size_t)D * FF * 2); add(WS_WIN, (size_t)INCOLS * D * 2); add(WS_WHG, (size_t)D * HK * 2); add(WS_WGLU, (size_t)2 * D * S5W * 2); add(WS_WOUT, (size_t)D * D * 2); }
        if (sel & 2) { add(WS_HRES, (size_t)MP * D * 4); add(WS_ABUF, (size_t)MP * D * 2); add(WS_PARTB, (size_t)MP * 32 * 4); }
        if (sel & 4) { add(WS_Q, (size_t)MP * HK * 2); add(WS_K, (size_t)MP * HK * 2); add(WS_V, (size_t)MP * HK * 2); add(WS_S5U, (size_t)MP * S5W * 4); }
        if (sel & 8) { add(WS_LOGF, (size_t)(MR + NMETA) * HK * 4); add(WS_DEC, (size_t)128 * NH * 128 * 4); }
        if (sel & 128) { add(WS_S5E, (size_t)128 * 2048 * 8); }
        if (sel & 16) { add(WS_GS, (size_t)MR * HK * 2); add(WS_Z, (size_t)MR * S5W * 2); }
        if (sel & 64) { add(WS_LOGF, (size_t)(MR + NMETA) * HK * 4); add(WS_GS, (size_t)MP * HK * 2); }
        if (sel & 32) { d.r[n].p = (const unsigned*)d_out; d.r[n].nwords = (size_t)128 * NH * 16384 * 2 / 4; ++n; }
        d.n = n; d.sums = (unsigned*)(ws + WS_END);
        hipMemsetAsync(ws + WS_END, 0, 256, stream);
        hipLaunchKernelGGL(dbg_sum, dim3(1024), dim3(256), 0, stream, d);
        hipLaunchKernelGGL(dbg_fill, dim3(1024), dim3(256), 0, stream, (float*)d_out, (const unsigned*)(ws + WS_END), n, (size_t)MR * D);
    }
#else
#ifdef PROBE_SEQ
    { const int seq[] = PROBE_SEQ; for (int i = 0; i < (int)(sizeof(seq) / sizeof(int)); ++i) { a.lo = seq[i]; a.hi = seq[i] + 1; hipLaunchKernelGGL(fwd, dim3(grid), dim3(512), 0, stream, a); } }
#else
    for (int p = 0; p < NPHASES; ++p) { a.lo = p; a.hi = p + 1; hipLaunchKernelGGL(fwd, dim3(grid), dim3(512), 0, stream, a); }
#endif
#endif
#else
    a.lo = 0; a.hi = NPHASES;
    void* args[] = {&a};
    hipError_t e = hipLaunchCooperativeKernel((const void*)fwd, dim3(grid), dim3(512), args, 0, stream);
    if (e != hipSuccess) fprintf(stderr, "kernel_launch: cooperative launch failed: %s (grid %d)\n", hipGetErrorString(e), grid);
#endif
}
```

```cpp
#include <hip/hip_runtime.h>
#include <hip/hip_cooperative_groups.h>
#include <cstdio>
namespace cg = cooperative_groups;

#ifndef MK_MULTI
#define MK_MULTI 0
#endif

namespace pg8 {
#define PG8_LAS __attribute__((address_space(3)))
typedef unsigned short bf16_t;
typedef short bf16x8 __attribute__((ext_vector_type(8)));
typedef float f32x4 __attribute__((ext_vector_type(4)));
typedef unsigned u32x4 __attribute__((ext_vector_type(4)));
typedef unsigned u32x2 __attribute__((ext_vector_type(2)));
constexpr int BM = 256, BK = 64, HALF = 128, HTB = HALF * BK * 2  , STAGE_BYTES = 8 * HTB, NXCD = 8, WGM = 8;

__host__ __device__ __forceinline__ int lds_byte(int r, int c) { const int st = (r >> 4) * 2 + (c >> 5), rr = r & 15, cc = c & 31, ob = rr * 64 + cc * 2; return st * 1024 + (ob ^ (((ob >> 9) & 1) << 5)); }
__host__ __device__ __forceinline__ void stage_rc(int b, int& R, int& C) { const int st = b / 1024, sb = b % 1024, swz = sb ^ (((sb >> 9) & 1) << 5); R = (st >> 1) * 16 + swz / 64; C = (st & 1) * 32 + (swz % 64) / 2; }
__host__ __device__ __forceinline__ int perm32(int rho) { const int n = rho >> 4, i = rho & 15; return 8 * (i >> 2) + 4 * n + (i & 3); }

struct Unit { int pm, pn; };
struct Gemm { const bf16_t* A; const bf16_t* Bt; int M, N, K; };

struct StaticOrder {
    int nM, nN, nwg, G, c;
    __host__ __device__ void init(int M, int N, int G_, int c_) { nM = M / BM; nN = N / BM; nwg = nM * nN; G = G_; c = c_; }
    __host__ __device__ bool next(int i, Unit& u) const {
        const long L = (long)i * G + c; if (L >= nwg) return false;
        int wgid = (int)L; { const int q = nwg / NXCD, r = nwg % NXCD, xcd = wgid % NXCD, off = wgid / NXCD; wgid = (xcd < r ? xcd * (q + 1) : r * (q + 1) + (xcd - r) * q) + off; }
        const int nig = WGM * nN, gid = wgid / nig, fm = gid * WGM, gsz = (nM - fm) < WGM ? (nM - fm) : WGM;
        u.pm = fm + ((wgid % nig) % gsz); u.pn = (wgid % nig) / gsz; return true;
    }
    __device__ __forceinline__ void a_ready(const Unit&) const {}
    __device__ __forceinline__ void done(const Unit&) const {}
};
typedef float f32x2v __attribute__((ext_vector_type(2)));
typedef __bf16 bf16x2v __attribute__((ext_vector_type(2)));
__device__ __forceinline__ unsigned cvt_pk_bf16(float lo, float hi) { const f32x2v v = {lo, hi}; const bf16x2v b = __builtin_convertvector(v, bf16x2v); return __builtin_bit_cast(unsigned, b); }

template <class Epi, class Sched>
__device__ __forceinline__ void gemm_phase(PG8_LAS unsigned char* lds, const Gemm g, const Sched& S, const Epi& E) {
    const int tid = threadIdx.x, wid = __builtin_amdgcn_readfirstlane(tid >> 6), lane = tid & 63, wr = wid >> 2, wc = wid & 3, fr = lane & 15, fq = lane >> 4;
    const int K = g.K, nt = K / BK;
    unsigned voffA[2], voffB[2];
#pragma unroll
    for (int i = 0; i < 2; ++i) { int R, C; stage_rc(tid * 16 + i * 8192, R, C); const int Rb = Epi::PERM ? ((R & ~31) + perm32(R & 31)) : R;
        voffA[i] = (unsigned)(R * K + C) * 2u; voffB[i] = (unsigned)(Rb * K + C) * 2u; }
    const size_t kstep = (size_t)(BK * 2);
    const size_t hstep = (size_t)HALF * K * 2;
    const size_t tstep = 2 * hstep;
    const unsigned ldsw = (unsigned)wid * 1024u;
    const int aoff = lds_byte(wr * 64 + fr, fq * 8), boff = lds_byte(wc * 32 + fr, fq * 8);
#define PG8_SA(b, h) (((b) * 2 + (h)) * HTB)
#define PG8_SB(b, h) ((4 + (b) * 2 + (h)) * HTB)
#define PG8_STAGE(bufoff, gbase, voff) do { _Pragma("unroll") for (int _i = 0; _i < 2; ++_i) \
        __builtin_amdgcn_global_load_lds((const unsigned*)((const char*)(gbase) + (voff)[_i]), (PG8_LAS unsigned*)(lds + (bufoff) + ldsw + _i * 8192), 16, 0, 0); } while (0)
#define PG8_LDA(dst, b, h) do { _Pragma("unroll") for (int m = 0; m < 4; ++m) _Pragma("unroll") for (int k = 0; k < 2; ++k) dst[m][k] = *(const PG8_LAS bf16x8*)(lds + PG8_SA(b, h) + aoff + m * 2048 + k * 1024); } while (0)
#define PG8_LDB(dst, b, h) do { _Pragma("unroll") for (int n = 0; n < 2; ++n) _Pragma("unroll") for (int k = 0; k < 2; ++k) dst[n][k] = *(const PG8_LAS bf16x8*)(lds + PG8_SB(b, h) + boff + n * 2048 + k * 1024); } while (0)
#define PG8_MMA(ai, bj, At, Bt) do { __builtin_amdgcn_s_setprio(1); _Pragma("unroll") for (int m = 0; m < 4; ++m) _Pragma("unroll") for (int n = 0; n < 2; ++n) _Pragma("unroll") for (int k = 0; k < 2; ++k) \
        acc[ai][bj][m][n] = __builtin_amdgcn_mfma_f32_16x16x32_bf16(Bt[n][k], At[m][k], acc[ai][bj][m][n], 0, 0, 0); __builtin_amdgcn_s_setprio(0); } while (0)
#define PG8_WAIT_V(n) asm volatile("s_waitcnt vmcnt(" #n ")" ::: "memory")
#define PG8_WAIT_L(n) asm volatile("s_waitcnt lgkmcnt(" #n ")" ::: "memory")
#define PG8_BAR __builtin_amdgcn_s_barrier()
#define PG8_SCHED __builtin_amdgcn_sched_barrier(0)
    Unit cur, nxt; int ui = 0;
    if (!S.next(0, cur)) return;
    f32x4 acc[2][2][4][2];
#pragma unroll
    for (int a = 0; a < 2; ++a)
#pragma unroll
        for (int b = 0; b < 2; ++b)
#pragma unroll
            for (int m = 0; m < 4; ++m)
#pragma unroll
                for (int n = 0; n < 2; ++n) acc[a][b][m][n] = (f32x4){0.f, 0.f, 0.f, 0.f};
    bf16x8 At[4][2], B0[2][2], B1[2][2];
    const char* cA = (const char*)g.A + (size_t)cur.pm * tstep; const char* cB = (const char*)g.Bt + (size_t)cur.pn * tstep;
    S.a_ready(cur);
    PG8_STAGE(PG8_SB(0, 0), cB, voffB); PG8_STAGE(PG8_SA(0, 0), cA, voffA); PG8_STAGE(PG8_SB(0, 1), cB + hstep, voffB); PG8_STAGE(PG8_SA(0, 1), cA + hstep, voffA);
    if (wr == 1) PG8_BAR;
    PG8_WAIT_V(4); PG8_BAR;
    PG8_STAGE(PG8_SB(1, 0), cB + kstep, voffB); PG8_STAGE(PG8_SA(1, 0), cA + kstep, voffA); PG8_STAGE(PG8_SB(1, 1), cB + hstep + kstep, voffB);
    PG8_WAIT_V(6); PG8_BAR;
    for (;;) {
        const bool has_next = S.next(ui + 1, nxt);
        const char* nA = has_next ? (const char*)g.A + (size_t)nxt.pm * tstep : cA; const char* nB = has_next ? (const char*)g.Bt + (size_t)nxt.pn * tstep : cB;
        for (int t = 0; t < nt; t += 2) {
            const bool last = (t == nt - 2);
            const char* a1 = cA + (size_t)(t + 1) * kstep;
            const char* a2 = last ? nA : cA + (size_t)(t + 2) * kstep; const char* b2 = last ? nB : cB + (size_t)(t + 2) * kstep;
            const char* a3 = a2 + kstep; const char* b3 = b2 + kstep;
            if (last && has_next) S.a_ready(nxt);
            PG8_LDB(B0, 0, 0); PG8_SCHED; PG8_LDA(At, 0, 0); PG8_STAGE(PG8_SA(1, 1), a1 + hstep, voffA);
            PG8_WAIT_L(8); PG8_BAR; PG8_WAIT_L(0); PG8_MMA(0, 0, At, B0); PG8_BAR; PG8_SCHED;
            PG8_LDB(B1, 0, 1); PG8_STAGE(PG8_SB(0, 0), b2, voffB);
            PG8_BAR; PG8_WAIT_L(0); PG8_MMA(0, 1, At, B1); PG8_BAR;
            PG8_LDA(At, 0, 1); PG8_STAGE(PG8_SA(0, 0), a2, voffA);
            PG8_BAR; PG8_WAIT_L(0); PG8_MMA(1, 0, At, B0); PG8_BAR; PG8_SCHED;
            PG8_STAGE(PG8_SB(0, 1), b2 + hstep, voffB);
            PG8_WAIT_V(6); PG8_BAR; PG8_MMA(1, 1, At, B1); PG8_BAR;
            PG8_LDB(B0, 1, 0); PG8_SCHED; PG8_LDA(At, 1, 0); PG8_STAGE(PG8_SA(0, 1), a2 + hstep, voffA);
            PG8_WAIT_L(8); PG8_BAR; PG8_WAIT_L(0); PG8_MMA(0, 0, At, B0); PG8_BAR; PG8_SCHED;
            PG8_LDB(B1, 1, 1); PG8_STAGE(PG8_SB(1, 0), b3, voffB);
            PG8_BAR; PG8_WAIT_L(0); PG8_MMA(0, 1, At, B1); PG8_BAR;
            PG8_LDA(At, 1, 1); PG8_STAGE(PG8_SA(1, 0), a3, voffA);
            PG8_BAR; PG8_WAIT_L(0); PG8_MMA(1, 0, At, B0); PG8_BAR; PG8_SCHED;
            PG8_STAGE(PG8_SB(1, 1), b3 + hstep, voffB);
            PG8_WAIT_V(6); PG8_BAR; PG8_MMA(1, 1, At, B1); PG8_BAR;
        }
        if constexpr (!Epi::AFTER_DRAIN) { E(acc, cur, wr, wc, fr, fq); S.done(cur); }
        if (!has_next) break;
#pragma unroll
        for (int a = 0; a < 2; ++a)
#pragma unroll
            for (int b = 0; b < 2; ++b)
#pragma unroll
                for (int m = 0; m < 4; ++m)
#pragma unroll
                    for (int n = 0; n < 2; ++n) acc[a][b][m][n] = (f32x4){0.f, 0.f, 0.f, 0.f};
        cur = nxt; cA = nA; cB = nB; ++ui;
    }
    PG8_WAIT_V(0);
    if (wr == 0) PG8_BAR;
    PG8_BAR;
    if constexpr (Epi::AFTER_DRAIN) { E.fused(acc, cur, wr, wc, fr, fq, lds, wid, lane); S.done(cur); }
#undef PG8_SA
#undef PG8_SB
#undef PG8_STAGE
#undef PG8_LDA
#undef PG8_LDB
#undef PG8_MMA
#undef PG8_WAIT_V
#undef PG8_WAIT_L
#undef PG8_BAR
#undef PG8_SCHED
}
}

using pg8::bf16_t; using pg8::bf16x8; using pg8::f32x4; using pg8::u32x4; using pg8::u32x2; using pg8::cvt_pk_bf16;
#define LAS __attribute__((address_space(3)))
constexpr int D = 2048, FF = 5632, MR = 8192, NMETA = 16, MP = 8448;
constexpr int HK = 1536, NH = 12, S5W = 512, NS = 64;
constexpr int NREC = 6656, NGATE = 4096, INCOLS = 10752, NCH = 129;
constexpr float EPS = 1e-6f;
constexpr int LDS_BYTES = 131072;

constexpr size_t WS_WGU  = 0;
constexpr size_t WS_WD   = WS_WGU  + (size_t)2 * FF * D * 2;
constexpr size_t WS_WIN  = WS_WD   + (size_t)D * FF * 2;
constexpr size_t WS_WHG  = WS_WIN  + (size_t)INCOLS * D * 2;
constexpr size_t WS_WGLU = WS_WHG  + (size_t)D * HK * 2;
constexpr size_t WS_WOUT = WS_WGLU + (size_t)2 * D * S5W * 2;
constexpr size_t WS_HRES = WS_WOUT + (size_t)D * D * 2;
constexpr size_t WS_ABUF = WS_HRES + (size_t)MP * D * 4;
constexpr size_t WS_Q    = WS_ABUF + (size_t)MP * D * 2;
constexpr size_t WS_K    = WS_Q    + (size_t)MP * HK * 2;
constexpr size_t WS_LOGF = WS_K    + (size_t)MP * HK * 2;
constexpr size_t WS_V    = WS_LOGF + (size_t)MP * HK * 4;
constexpr size_t WS_GS   = WS_V    + (size_t)MP * HK * 2;
constexpr size_t WS_S5U  = WS_GS   + (size_t)MP * HK * 2;
constexpr size_t WS_Z    = WS_S5U  + (size_t)MP * S5W * 4;
constexpr size_t WS_PARTA= WS_Z    + (size_t)MR * S5W * 2;
constexpr size_t WS_PARTB= WS_PARTA+ (size_t)MP * 32 * 4;
constexpr size_t WS_DEC  = WS_PARTB+ (size_t)MP * 32 * 4;
constexpr size_t WS_S5E  = WS_DEC  + (size_t)128 * NH * 128 * 4;
constexpr size_t WS_END  = WS_S5E  + (size_t)NCH * 2048 * 8;
constexpr size_t WS_H     = WS_Q;
constexpr size_t WS_GATES = WS_Q;
static_assert((size_t)MP * FF * 2 <= WS_V - WS_Q, "H alias");
constexpr size_t DO_YS = 0, DO_MERGED = (size_t)MR * D * 2;

struct Args { const float* in[27]; float* out; unsigned char* ws; int lo, hi; };

__device__ __forceinline__ float bf_lo(unsigned w) { return __uint_as_float(w << 16); }
__device__ __forceinline__ float bf_hi(unsigned w) { return __uint_as_float(w & 0xffff0000u); }
__device__ __forceinline__ float bf2f(bf16_t b) { return __uint_as_float(((unsigned)b) << 16); }
__device__ __forceinline__ float fsigmoid(float x) { return __builtin_amdgcn_rcpf(1.0f + __expf(-x)); }
__device__ __forceinline__ float fsilu(float x) { return x * fsigmoid(x); }
#define LDS_WAIT() asm volatile("s_waitcnt lgkmcnt(0)" ::: "memory")

__device__ __forceinline__ void row_rstd(const float* part, int row0, int fq, float (&rs)[2][4]) {
#pragma unroll
    for (int ai = 0; ai < 2; ++ai)
#pragma unroll
        for (int m = 0; m < 4; ++m) {
            const f32x4* p = (const f32x4*)(part + (size_t)(row0 + ai * 128 + m * 16) * 32 + fq * 8);
            const f32x4 a = p[0], b = p[1];
            float s = ((a.x + a.y) + (a.z + a.w)) + ((b.x + b.y) + (b.z + b.w));
            s += __shfl_xor(s, 16); s += __shfl_xor(s, 32);
            rs[ai][m] = rsqrtf(s * (1.0f / D) + EPS);
        }
}
struct EpiSwiglu {
    static constexpr bool PERM = true, AFTER_DRAIN = false;
    bf16_t* H; const float* part;
    __device__ __forceinline__ void operator()(const f32x4 (&acc)[2][2][4][2], const pg8::Unit& u, int wr, int wc, int fr, int fq) const {
        const int row0 = u.pm * 256 + wr * 64 + fr, col0 = u.pn * 128 + wc * 32 + 8 * fq;
        float rs[2][4]; row_rstd(part, row0, fq, rs);
#pragma unroll
        for (int ai = 0; ai < 2; ++ai)
#pragma unroll
            for (int m = 0; m < 4; ++m) {
                const float r = rs[ai][m]; float h[8];
#pragma unroll
                for (int n = 0; n < 2; ++n)
#pragma unroll
                    for (int j = 0; j < 4; ++j) h[n * 4 + j] = fsilu(acc[ai][0][m][n][j] * r) * (acc[ai][1][m][n][j] * r);
                u32x4 w; w.x = cvt_pk_bf16(h[0], h[1]); w.y = cvt_pk_bf16(h[2], h[3]); w.z = cvt_pk_bf16(h[4], h[5]); w.w = cvt_pk_bf16(h[6], h[7]);
                *(u32x4*)(H + (size_t)(row0 + ai * 128 + m * 16) * FF + col0) = w;
            }
    }
};
struct EpiRes {
    static constexpr bool PERM = false, AFTER_DRAIN = false;
    const float* res; const float* x; const float* meta; float* out; bf16_t* outb; float* part; float alpha; int mode;
    __device__ __forceinline__ void operator()(const f32x4 (&acc)[2][2][4][2], const pg8::Unit& u, int wr, int wc, int fr, int fq) const {
        const int row0 = u.pm * 256 + wr * 64 + fr, col0 = u.pn * 256 + wc * 32 + 4 * fq;
#pragma unroll
        for (int ai = 0; ai < 2; ++ai)
#pragma unroll
            for (int m = 0; m < 4; ++m) {
                const int row = row0 + ai * 128 + m * 16;
                const float* rp = mode ? res + (size_t)row * D : (row < MR ? x + (size_t)row * D : (row < MR + NMETA ? meta + (size_t)(row - MR) * D : nullptr));
                float ss = 0.f;
#pragma unroll
                for (int bj = 0; bj < 2; ++bj)
#pragma unroll
                    for (int n = 0; n < 2; ++n) {
                        const int c = col0 + bj * 128 + n * 16;
                        f32x4 r = rp ? *(const f32x4*)(rp + c) : (f32x4){0.f, 0.f, 0.f, 0.f};
                        const f32x4 o = r + acc[ai][bj][m][n] * alpha;
                        *(f32x4*)(out + (size_t)row * D + c) = o;
                        ss += (o.x * o.x + o.y * o.y) + (o.z * o.z + o.w * o.w);
                        if (outb) { u32x2 w; w.x = cvt_pk_bf16(o.x, o.y); w.y = cvt_pk_bf16(o.z, o.w); *(u32x2*)(outb + (size_t)row * D + c) = w; }
                    }
                ss += __shfl_xor(ss, 16); ss += __shfl_xor(ss, 32);
                if (fq == 0) part[(size_t)row * 32 + u.pn * 4 + wc] = ss;
            }
    }
};
struct EpiRec {
    static constexpr bool PERM = true, AFTER_DRAIN = false;
    bf16_t *Q, *Kb, *V, *GS; float *LOGF, *S5U; const float* part; const float* lbp;
    __device__ __forceinline__ void operator()(const f32x4 (&acc)[2][2][4][2], const pg8::Unit& u, int wr, int wc, int fr, int fq) const {
        const int row0 = u.pm * 256 + wr * 64 + fr, colt = u.pn * 256 + wc * 32 + 8 * fq;
        float rs[2][4]; row_rstd(part, row0, fq, rs);
        const int seg = u.pn < 6 ? 0 : (u.pn < 12 ? 1 : (u.pn < 18 ? 2 : (u.pn < 24 ? 3 : 4)));
#pragma unroll
        for (int bj = 0; bj < 2; ++bj) {
            const int c = colt + bj * 128;
            float lb[8];
            if (seg == 1) {
#pragma unroll
                for (int e = 0; e < 8; ++e) { const float a0 = lbp[c - HK + e], a1 = lbp[HK + c - HK + e]; lb[e] = 1.0f / (1.0f + expf(a1 - a0)); }
            }
#pragma unroll
            for (int ai = 0; ai < 2; ++ai)
#pragma unroll
                for (int m = 0; m < 4; ++m) {
                    const size_t row = (size_t)(row0 + ai * 128 + m * 16); const float r = rs[ai][m];
                    float v[8];
#pragma unroll
                    for (int n = 0; n < 2; ++n)
#pragma unroll
                        for (int j = 0; j < 4; ++j) v[n * 4 + j] = acc[ai][bj][m][n][j] * r;
                    if (seg == 0) {
#pragma unroll
                        for (int e = 0; e < 8; ++e) v[e] = fsilu(v[e]) * 0.08838834764831845f;
                        u32x4 w; w.x = cvt_pk_bf16(v[0], v[1]); w.y = cvt_pk_bf16(v[2], v[3]); w.z = cvt_pk_bf16(v[4], v[5]); w.w = cvt_pk_bf16(v[6], v[7]);
                        *(u32x4*)(Q + row * HK + c) = w;
                    } else if (seg == 1) {
                        float kk[8], lf[8];
#pragma unroll
                        for (int e = 0; e < 8; ++e) { const float sg = 1.0f / (1.0f + __expf(-v[e])); const float f = lb[e] + (1.0f - lb[e]) * sg; kk[e] = 1.0f - f; lf[e] = __logf(f); }
                        u32x4 w; w.x = cvt_pk_bf16(kk[0], kk[1]); w.y = cvt_pk_bf16(kk[2], kk[3]); w.z = cvt_pk_bf16(kk[4], kk[5]); w.w = cvt_pk_bf16(kk[6], kk[7]);
                        *(u32x4*)(Kb + row * HK + (c - HK)) = w;
                        *(f32x4*)(LOGF + row * HK + (c - HK)) = (f32x4){lf[0], lf[1], lf[2], lf[3]};
                        *(f32x4*)(LOGF + row * HK + (c - HK) + 4) = (f32x4){lf[4], lf[5], lf[6], lf[7]};
                    } else if (seg == 2) {
                        u32x4 w; w.x = cvt_pk_bf16(v[0], v[1]); w.y = cvt_pk_bf16(v[2], v[3]); w.z = cvt_pk_bf16(v[4], v[5]); w.w = cvt_pk_bf16(v[6], v[7]);
                        *(u32x4*)(V + row * HK + (c - 2 * HK)) = w;
                    } else if (seg == 3) {
#pragma unroll
                        for (int e = 0; e < 8; ++e) v[e] = fsilu(v[e]);
                        u32x4 w; w.x = cvt_pk_bf16(v[0], v[1]); w.y = cvt_pk_bf16(v[2], v[3]); w.z = cvt_pk_bf16(v[4], v[5]); w.w = cvt_pk_bf16(v[6], v[7]);
                        *(u32x4*)(GS + row * HK + (c - 3 * HK)) = w;
                    } else {
                        *(f32x4*)(S5U + row * S5W + (c - 4 * HK)) = (f32x4){v[0], v[1], v[2], v[3]};
                        *(f32x4*)(S5U + row * S5W + (c - 4 * HK) + 4) = (f32x4){v[4], v[5], v[6], v[7]};
                    }
                }
        }
    }
};
struct EpiGates {
    static constexpr bool PERM = true, AFTER_DRAIN = false;
    bf16_t* G; const float* part;
    __device__ __forceinline__ void operator()(const f32x4 (&acc)[2][2][4][2], const pg8::Unit& u, int wr, int wc, int fr, int fq) const {
        const int row0 = u.pm * 256 + wr * 64 + fr, colt = u.pn * 256 + wc * 32 + 8 * fq;
        float rs[2][4]; row_rstd(part, row0, fq, rs);
#pragma unroll
        for (int ai = 0; ai < 2; ++ai)
#pragma unroll
            for (int m = 0; m < 4; ++m) {
                const float r = rs[ai][m];
#pragma unroll
                for (int bj = 0; bj < 2; ++bj) {
                    float v[8];
#pragma unroll
                    for (int n = 0; n < 2; ++n)
#pragma unroll
                        for (int j = 0; j < 4; ++j) v[n * 4 + j] = fsigmoid(acc[ai][bj][m][n][j] * r);
                    u32x4 w; w.x = cvt_pk_bf16(v[0], v[1]); w.y = cvt_pk_bf16(v[2], v[3]); w.z = cvt_pk_bf16(v[4], v[5]); w.w = cvt_pk_bf16(v[6], v[7]);
                    *(u32x4*)(G + (size_t)(row0 + ai * 128 + m * 16) * NGATE + colt + bj * 128) = w;
                }
            }
    }
};
struct EpiGlu {
    static constexpr bool PERM = true, AFTER_DRAIN = false;
    const bf16_t* G; bf16_t* YS;
    __device__ __forceinline__ void operator()(const f32x4 (&acc)[2][2][4][2], const pg8::Unit& u, int wr, int wc, int fr, int fq) const {
        const int row0 = u.pm * 256 + wr * 64 + fr, col0 = u.pn * 128 + wc * 32 + 8 * fq;
#pragma unroll
        for (int ai = 0; ai < 2; ++ai)
#pragma unroll
            for (int m = 0; m < 4; ++m) {
                const size_t row = (size_t)(row0 + ai * 128 + m * 16);
                const u32x4 gw = *(const u32x4*)(G + row * NGATE + D + col0);
                const float g[8] = {bf_lo(gw.x), bf_hi(gw.x), bf_lo(gw.y), bf_hi(gw.y), bf_lo(gw.z), bf_hi(gw.z), bf_lo(gw.w), bf_hi(gw.w)};
                float y[8];
#pragma unroll
                for (int n = 0; n < 2; ++n)
#pragma unroll
                    for (int j = 0; j < 4; ++j) y[n * 4 + j] = g[n * 4 + j] * acc[ai][0][m][n][j] * fsigmoid(acc[ai][1][m][n][j]);
                u32x4 w; w.x = cvt_pk_bf16(y[0], y[1]); w.y = cvt_pk_bf16(y[2], y[3]); w.z = cvt_pk_bf16(y[4], y[5]); w.w = cvt_pk_bf16(y[6], y[7]);
                *(u32x4*)(YS + row * D + col0) = w;
            }
    }
};
struct EpiMerge {
    static constexpr bool PERM = true, AFTER_DRAIN = false;
    const bf16_t* G; const bf16_t* YS; bf16_t* MG;
    __device__ __forceinline__ void operator()(const f32x4 (&acc)[2][2][4][2], const pg8::Unit& u, int wr, int wc, int fr, int fq) const {
        const int row0 = u.pm * 256 + wr * 64 + fr, colt = u.pn * 256 + wc * 32 + 8 * fq;
#pragma unroll
        for (int ai = 0; ai < 2; ++ai)
#pragma unroll
            for (int m = 0; m < 4; ++m) {
                const size_t row = (size_t)(row0 + ai * 128 + m * 16);
#pragma unroll
                for (int bj = 0; bj < 2; ++bj) {
                    const int c = colt + bj * 128;
                    const u32x4 gw = *(const u32x4*)(G + row * NGATE + c), yw = *(const u32x4*)(YS + row * D + c);
                    const float g[8] = {bf_lo(gw.x), bf_hi(gw.x), bf_lo(gw.y), bf_hi(gw.y), bf_lo(gw.z), bf_hi(gw.z), bf_lo(gw.w), bf_hi(gw.w)};
                    const float y[8] = {bf_lo(yw.x), bf_hi(yw.x), bf_lo(yw.y), bf_hi(yw.y), bf_lo(yw.z), bf_hi(yw.z), bf_lo(yw.w), bf_hi(yw.w)};
                    float o[8];
#pragma unroll
                    for (int n = 0; n < 2; ++n)
#pragma unroll
                        for (int j = 0; j < 4; ++j) o[n * 4 + j] = g[n * 4 + j] * acc[ai][bj][m][n][j] + y[n * 4 + j];
                    u32x4 w; w.x = cvt_pk_bf16(o[0], o[1]); w.y = cvt_pk_bf16(o[2], o[3]); w.z = cvt_pk_bf16(o[4], o[5]); w.w = cvt_pk_bf16(o[6], o[7]);
                    *(u32x4*)(MG + row * D + c) = w;
                }
            }
    }
};

__device__ __forceinline__ float wave_sum(float v) {
#pragma unroll
    for (int o = 1; o < 64; o <<= 1) v += __shfl_xor(v, o);
    return v;
}
__device__ __forceinline__ void tr_item(const float* W, int K, int N, bf16_t* WT, const float* gain, int ilv, LAS float* scr, int item, int lane) {
    const int nblk = N / 32, kb = item / nblk, nb = item - kb * nblk, k0 = 64 * kb, n0 = 32 * nb;
    float wv[32];
    const float* wp = W + (size_t)(k0 + (lane >> 5)) * N + n0 + (lane & 31);
#pragma unroll
    for (int i = 0; i < 32; ++i) wv[i] = __builtin_nontemporal_load(wp + (size_t)(2 * i) * N);
    const float gl = gain ? gain[k0 + lane] : 1.0f;
#pragma unroll
    for (int i = 0; i < 32; ++i) { const float g0 = __int_as_float(__builtin_amdgcn_readlane(__float_as_int(gl), 2 * i)), g1 = __int_as_float(__builtin_amdgcn_readlane(__float_as_int(gl), 2 * i + 1)); scr[(2 * i + (lane >> 5)) * 33 + (lane & 31)] = wv[i] * ((lane >> 5) ? g1 : g0); }
    LDS_WAIT();
    const int c = lane & 7;
#pragma unroll
    for (int j = 0; j < 4; ++j) { const int n = (lane >> 3) + 8 * j; const LAS float* s = scr + (8 * c) * 33 + n;
        u32x4 o; o.x = cvt_pk_bf16(s[0 * 33], s[1 * 33]); o.y = cvt_pk_bf16(s[2 * 33], s[3 * 33]); o.z = cvt_pk_bf16(s[4 * 33], s[5 * 33]); o.w = cvt_pk_bf16(s[6 * 33], s[7 * 33]);
        const int nn = n0 + n; const int drow = ilv ? ((nn >> 7) * 256 + (ilv - 1) * 128 + (nn & 127)) : nn;
        *(u32x4*)(WT + (size_t)drow * K + k0 + 8 * c) = o; }
    LDS_WAIT();
}
struct TrJob { const float* W; int K, N; bf16_t* WT; const float* gain; int ilv; };
__device__ __forceinline__ void tr_run(const TrJob& j, int& it, int NGW, LAS float* scr, int lane) {
    const int n = (j.K / 64) * (j.N / 32);
    for (; it < n; it += NGW) tr_item(j.W, j.K, j.N, j.WT, j.gain, j.ilv, scr, it, lane);
    it -= n;
}

__device__ __forceinline__ void skinny_down(LAS unsigned char* lds, int tile, const bf16_t* Hm, const bf16_t* Wd, const float* meta, bf16_t* ABUF, float* PARTB, int wave, int lane) {
    const int lr = lane & 15, lq = lane >> 4, n0 = 16 * tile, kbase = wave * (FF / 8);
    const bf16_t* ap = Hm + (size_t)lr * FF + kbase + 8 * lq; const bf16_t* bp = Wd + (size_t)(n0 + lr) * FF + kbase + 8 * lq;
    f32x4 acc = (f32x4){0.f, 0.f, 0.f, 0.f};
#pragma unroll 11
    for (int s = 0; s < FF / 8 / 32; ++s) { const bf16x8 af = *(const bf16x8*)(ap + 32 * s), bf = *(const bf16x8*)(bp + 32 * s); acc = __builtin_amdgcn_mfma_f32_16x16x32_bf16(bf, af, acc, 0, 0, 0); }
    *(LAS f32x4*)(lds + (wave * 64 + lane) * 16) = acc;
    __syncthreads();
    if (wave == 0) {
        f32x4 t = (f32x4){0.f, 0.f, 0.f, 0.f};
#pragma unroll
        for (int w = 0; w < 8; ++w) t += *(const LAS f32x4*)(lds + (w * 64 + lane) * 16);
        const int col = n0 + 4 * lq; const f32x4 r = *(const f32x4*)(meta + (size_t)lr * D + col); const f32x4 o = r + t * 0.5f;
        u32x2 w2; w2.x = cvt_pk_bf16(o.x, o.y); w2.y = cvt_pk_bf16(o.z, o.w); *(u32x2*)(ABUF + (size_t)(MR + lr) * D + col) = w2;
        float ss = (o.x * o.x + o.y * o.y) + (o.z * o.z + o.w * o.w); ss += __shfl_xor(ss, 16); ss += __shfl_xor(ss, 32);
        if (lq == 0) atomicAdd(PARTB + (size_t)(MR + lr) * 32 + (tile & 31), ss);
    }
    __syncthreads();
}

constexpr int HG_A1 = 0, HG_A2 = 17408, HG_BK = 34816, HG_ST = 52224, HG_VT = 87040, HG_P = 105472, HG_SSQ = 114688;
constexpr int HL_KT = 0, HL_VT = 18432, HL_QT = 36864;
__device__ __forceinline__ void hg_local_item(LAS unsigned char* lds, int item, float* LOGF, const bf16_t* Kb, const bf16_t* Vb, bf16_t* ST, float* DEC, int tid, int wave, int lane) {
    const int c = item / NH, h = item - c * NH;
    const int row0 = c == 0 ? MR : 64 * (c - 1), T = c == 0 ? NMETA : 64;
    const int kcol = tid & 127, tq = tid >> 7;
    float* LF = LOGF + (size_t)row0 * HK + h * 128 + kcol;
    LAS float* qt = (LAS float*)(lds + HL_QT);
    float cs[16]; float run = 0.f; unsigned kraw[16], vv[16];
    {
        const bf16_t* KP = Kb + (size_t)row0 * HK + h * 128 + kcol; const bf16_t* VP = Vb + (size_t)row0 * HK + h * 128 + kcol;
#pragma unroll
        for (int i = 0; i < 16; ++i) { const int t = tq * 16 + i; const bool ok = t < T; cs[i] = ok ? LF[(size_t)t * HK] : 0.f; kraw[i] = ok ? (unsigned)KP[(size_t)t * HK] : 0u; vv[i] = ok ? (unsigned)VP[(size_t)t * HK] : 0u; }
    }
#pragma unroll
    for (int i = 0; i < 16; ++i) { run += cs[i]; cs[i] = run; }
    qt[tq * 128 + kcol] = run;
    __syncthreads();
    float pre = 0.f, tot = 0.f;
#pragma unroll
    for (int q = 0; q < 4; ++q) { const float x = qt[q * 128 + kcol]; tot += x; if (q < tq) pre += x; }
#pragma unroll
    for (int i = 0; i < 16; ++i) { const int t = tq * 16 + i; cs[i] += pre; if (t < T) LF[(size_t)t * HK] = cs[i]; }
    if (c == NCH - 1) { __syncthreads(); return; }
    {
        float kd[16];
#pragma unroll
        for (int i = 0; i < 16; ++i) kd[i] = __uint_as_float(kraw[i] << 16) * __expf(tot - cs[i]);
        u32x4 a, b;
        a.x = cvt_pk_bf16(kd[0], kd[1]); a.y = cvt_pk_bf16(kd[2], kd[3]); a.z = cvt_pk_bf16(kd[4], kd[5]); a.w = cvt_pk_bf16(kd[6], kd[7]);
        b.x = cvt_pk_bf16(kd[8], kd[9]); b.y = cvt_pk_bf16(kd[10], kd[11]); b.z = cvt_pk_bf16(kd[12], kd[13]); b.w = cvt_pk_bf16(kd[14], kd[15]);
        *(LAS u32x4*)(lds + HL_KT + kcol * 144 + tq * 32) = a; *(LAS u32x4*)(lds + HL_KT + kcol * 144 + tq * 32 + 16) = b;
        a.x = vv[0] | (vv[1] << 16); a.y = vv[2] | (vv[3] << 16); a.z = vv[4] | (vv[5] << 16); a.w = vv[6] | (vv[7] << 16);
        b.x = vv[8] | (vv[9] << 16); b.y = vv[10] | (vv[11] << 16); b.z = vv[12] | (vv[13] << 16); b.w = vv[14] | (vv[15] << 16);
        *(LAS u32x4*)(lds + HL_VT + kcol * 144 + tq * 32) = a; *(LAS u32x4*)(lds + HL_VT + kcol * 144 + tq * 32 + 16) = b;
        if (tq == 0) DEC[(size_t)(c * NH + h) * 128 + kcol] = __expf(tot);
    }
    __syncthreads();
    {
        const int vt0 = (wave >> 1) * 2, kt0 = (wave & 1) * 4, lr = lane & 15, lq = lane >> 4;
        f32x4 acc[2][4];
#pragma unroll
        for (int a = 0; a < 2; ++a)
#pragma unroll
            for (int b = 0; b < 4; ++b) acc[a][b] = (f32x4){0.f, 0.f, 0.f, 0.f};
#pragma unroll
        for (int ks = 0; ks < 2; ++ks) {
            bf16x8 vf[2], kf[4];
#pragma unroll
            for (int a = 0; a < 2; ++a) vf[a] = *(const LAS bf16x8*)(lds + HL_VT + (16 * (vt0 + a) + lr) * 144 + (ks * 32 + 8 * lq) * 2);
#pragma unroll
            for (int b = 0; b < 4; ++b) kf[b] = *(const LAS bf16x8*)(lds + HL_KT + (16 * (kt0 + b) + lr) * 144 + (ks * 32 + 8 * lq) * 2);
#pragma unroll
            for (int a = 0; a < 2; ++a)
#pragma unroll
                for (int b = 0; b < 4; ++b) acc[a][b] = __builtin_amdgcn_mfma_f32_16x16x32_bf16(kf[b], vf[a], acc[a][b], 0, 0, 0);
        }
        bf16_t* dst = ST + (size_t)(c * NH + h) * 16384;
#pragma unroll
        for (int a = 0; a < 2; ++a)
#pragma unroll
            for (int b = 0; b < 4; ++b) { const int v = 16 * (vt0 + a) + lr, k = 16 * (kt0 + b) + 4 * lq;
                u32x2 w; w.x = cvt_pk_bf16(acc[a][b].x, acc[a][b].y); w.y = cvt_pk_bf16(acc[a][b].z, acc[a][b].w);
                *(u32x2*)(dst + v * 128 + k) = w; }
    }
    __syncthreads();
}
__device__ __forceinline__ void hg_out_item(LAS unsigned char* lds, int item, const float* B, const bf16_t* Q, const bf16_t* Kb, const bf16_t* Vb, const bf16_t* ST, bf16_t* GS, const float* hg_norm, int tid, int wave, int lane) {
    const int c = 1 + item / NH, h = item % NH, row0 = 64 * (c - 1);
    u32x2 gpre[4];
#pragma unroll
    for (int tt = 0; tt < 4; ++tt) gpre[tt] = *(const u32x2*)(GS + (size_t)(row0 + 16 * tt + (lane & 15)) * HK + h * 128 + 16 * wave + 4 * (lane >> 4));
#pragma unroll
    for (int jj = 0; jj < 2; ++jj) {
        const int p = tid + 512 * jj, t = p >> 4, k0 = 8 * (p & 15);
        const size_t off = (size_t)(row0 + t) * HK + h * 128 + k0, roff = (size_t)(row0 + 31) * HK + h * 128 + k0;
        const f32x4 b0 = *(const f32x4*)(B + off), b1 = *(const f32x4*)(B + off + 4), r0 = *(const f32x4*)(B + roff), r1 = *(const f32x4*)(B + roff + 4);
        const u32x4 qw = *(const u32x4*)(Q + off), kw = *(const u32x4*)(Kb + off);
        const float bb[8] = {b0.x, b0.y, b0.z, b0.w, b1.x, b1.y, b1.z, b1.w}, rr[8] = {r0.x, r0.y, r0.z, r0.w, r1.x, r1.y, r1.z, r1.w};
        const float qq[8] = {bf_lo(qw.x), bf_hi(qw.x), bf_lo(qw.y), bf_hi(qw.y), bf_lo(qw.z), bf_hi(qw.z), bf_lo(qw.w), bf_hi(qw.w)};
        const float kk[8] = {bf_lo(kw.x), bf_hi(kw.x), bf_lo(kw.y), bf_hi(kw.y), bf_lo(kw.z), bf_hi(kw.z), bf_lo(kw.w), bf_hi(kw.w)};
        float a1[8], a2[8], bk[8];
#pragma unroll
        for (int e = 0; e < 8; ++e) { a1[e] = qq[e] * __expf(bb[e]); a2[e] = qq[e] * __expf(bb[e] - rr[e]); bk[e] = kk[e] * __expf(rr[e] - bb[e]); }
        u32x4 w;
        w.x = cvt_pk_bf16(a1[0], a1[1]); w.y = cvt_pk_bf16(a1[2], a1[3]); w.z = cvt_pk_bf16(a1[4], a1[5]); w.w = cvt_pk_bf16(a1[6], a1[7]); *(LAS u32x4*)(lds + HG_A1 + t * 272 + k0 * 2) = w;
        w.x = cvt_pk_bf16(a2[0], a2[1]); w.y = cvt_pk_bf16(a2[2], a2[3]); w.z = cvt_pk_bf16(a2[4], a2[5]); w.w = cvt_pk_bf16(a2[6], a2[7]); *(LAS u32x4*)(lds + HG_A2 + t * 272 + k0 * 2) = w;
        w.x = cvt_pk_bf16(bk[0], bk[1]); w.y = cvt_pk_bf16(bk[2], bk[3]); w.z = cvt_pk_bf16(bk[4], bk[5]); w.w = cvt_pk_bf16(bk[6], bk[7]); *(LAS u32x4*)(lds + HG_BK + t * 272 + k0 * 2) = w;
    }
    {
        const int vcol = tid & 127, tq = tid >> 7; const bf16_t* VP = Vb + (size_t)(row0 + tq * 16) * HK + h * 128 + vcol; unsigned vv[16];
#pragma unroll
        for (int i = 0; i < 16; ++i) vv[i] = (unsigned)VP[(size_t)i * HK];
        u32x4 a, b;
        a.x = vv[0] | (vv[1] << 16); a.y = vv[2] | (vv[3] << 16); a.z = vv[4] | (vv[5] << 16); a.w = vv[6] | (vv[7] << 16);
        b.x = vv[8] | (vv[9] << 16); b.y = vv[10] | (vv[11] << 16); b.z = vv[12] | (vv[13] << 16); b.w = vv[14] | (vv[15] << 16);
        *(LAS u32x4*)(lds + HG_VT + vcol * 144 + tq * 32) = a; *(LAS u32x4*)(lds + HG_VT + vcol * 144 + tq * 32 + 16) = b;
    }
    {
        const u32x4* src = (const u32x4*)(ST + (size_t)(c * NH + h) * 16384);
#pragma unroll
        for (int jj = 0; jj < 4; ++jj) { const int idx = tid + 512 * jj; *(LAS u32x4*)(lds + HG_ST + (idx >> 4) * 272 + (idx & 15) * 16) = src[idx]; }
    }
    __syncthreads();
    const int lr = lane & 15, lq = lane >> 4;
    {
        const int tt = wave >> 1;
#pragma unroll
        for (int sh = 0; sh < 2; ++sh) {
            const int ss = 2 * (wave & 1) + sh;
            f32x4 acc = (f32x4){0.f, 0.f, 0.f, 0.f};
            if (ss <= tt) {
#pragma unroll
                for (int ks = 0; ks < 4; ++ks) {
                    const bf16x8 af = *(const LAS bf16x8*)(lds + HG_A2 + (16 * tt + lr) * 272 + (ks * 32 + 8 * lq) * 2);
                    const bf16x8 bf = *(const LAS bf16x8*)(lds + HG_BK + (16 * ss + lr) * 272 + (ks * 32 + 8 * lq) * 2);
                    acc = __builtin_amdgcn_mfma_f32_16x16x32_bf16(bf, af, acc, 0, 0, 0);
                }
            }
            const int t = 16 * tt + lr, s0 = 16 * ss + 4 * lq;
            float pv[4];
#pragma unroll
            for (int r = 0; r < 4; ++r) pv[r] = (s0 + r <= t) ? acc[r] : 0.f;
            u32x2 w; w.x = cvt_pk_bf16(pv[0], pv[1]); w.y = cvt_pk_bf16(pv[2], pv[3]);
            *(LAS u32x2*)(lds + HG_P + t * 144 + s0 * 2) = w;
        }
    }
    __syncthreads();
    f32x4 acc[4];
#pragma unroll
    for (int tt = 0; tt < 4; ++tt) acc[tt] = (f32x4){0.f, 0.f, 0.f, 0.f};
#pragma unroll
    for (int ks = 0; ks < 4; ++ks) {
        const bf16x8 sf = *(const LAS bf16x8*)(lds + HG_ST + (16 * wave + lr) * 272 + (ks * 32 + 8 * lq) * 2);
#pragma unroll
        for (int tt = 0; tt < 4; ++tt) { const bf16x8 af = *(const LAS bf16x8*)(lds + HG_A1 + (16 * tt + lr) * 272 + (ks * 32 + 8 * lq) * 2);
            acc[tt] = __builtin_amdgcn_mfma_f32_16x16x32_bf16(sf, af, acc[tt], 0, 0, 0); }
    }
#pragma unroll
    for (int ks = 0; ks < 2; ++ks) {
        const bf16x8 vf = *(const LAS bf16x8*)(lds + HG_VT + (16 * wave + lr) * 144 + (ks * 32 + 8 * lq) * 2);
#pragma unroll
        for (int tt = 0; tt < 4; ++tt) { const bf16x8 pf = *(const LAS bf16x8*)(lds + HG_P + (16 * tt + lr) * 144 + (ks * 32 + 8 * lq) * 2);
            acc[tt] = __builtin_amdgcn_mfma_f32_16x16x32_bf16(vf, pf, acc[tt], 0, 0, 0); }
    }
    LAS float* ssq = (LAS float*)(lds + HG_SSQ);
#pragma unroll
    for (int tt = 0; tt < 4; ++tt) { float s = (acc[tt].x * acc[tt].x + acc[tt].y * acc[tt].y) + (acc[tt].z * acc[tt].z + acc[tt].w * acc[tt].w);
        s += __shfl_xor(s, 16); s += __shfl_xor(s, 32); if (lq == 0) ssq[wave * 64 + 16 * tt + lr] = s; }
    __syncthreads();
    {
        const int col = h * 128 + 16 * wave + 4 * lq; const f32x4 hn = *(const f32x4*)(hg_norm + col);
#pragma unroll
        for (int tt = 0; tt < 4; ++tt) { const int t = 16 * tt + lr; float tot = 0.f;
#pragma unroll
            for (int w8 = 0; w8 < 8; ++w8) tot += ssq[w8 * 64 + t];
            const float rinv = rsqrtf(tot * (1.0f / 128.0f) + EPS);
            bf16_t* gp = GS + (size_t)(row0 + t) * HK + col; const u32x2 gw = gpre[tt];
            u32x2 w; w.x = cvt_pk_bf16(acc[tt].x * rinv * hn.x * bf_lo(gw.x), acc[tt].y * rinv * hn.y * bf_hi(gw.x));
            w.y = cvt_pk_bf16(acc[tt].z * rinv * hn.z * bf_lo(gw.y), acc[tt].w * rinv * hn.w * bf_hi(gw.y));
            *(u32x2*)gp = w; }
    }
    __syncthreads();
}

__device__ __forceinline__ void sincos_d(double x, double& s, double& c) {
    const double kq = rint(x * 0.63661977236758134308);
    double r = fma(-kq, 1.57079632679489655800, x); r = fma(-kq, 6.12323399573676603587e-17, r);
    const double r2 = r * r;
    double sp = 1.0 / 6227020800.0; sp = fma(sp, r2, -1.0 / 39916800.0); sp = fma(sp, r2, 1.0 / 362880.0); sp = fma(sp, r2, -1.0 / 5040.0); sp = fma(sp, r2, 1.0 / 120.0); sp = fma(sp, r2, -1.0 / 6.0); sp = fma(sp * r2, r, r);
    double cp = -1.0 / 87178291200.0; cp = fma(cp, r2, 1.0 / 479001600.0); cp = fma(cp, r2, -1.0 / 3628800.0); cp = fma(cp, r2, 1.0 / 40320.0); cp = fma(cp, r2, -1.0 / 720.0); cp = fma(cp, r2, 1.0 / 24.0); cp = fma(cp, r2, -0.5); cp = fma(cp, r2, 1.0);
    const int q = ((int)kq) & 3;
    s = (q == 0) ? sp : (q == 1) ? cp : (q == 2) ? -sp : -cp;
    c = (q == 0) ? cp : (q == 1) ? -sp : (q == 2) ? -cp : sp;
}
struct S5In { const float *lam_re, *lam_im, *log_step, *b_re, *b_im, *c_re, *c_im, *d; };
__device__ __forceinline__ void s5_abar(const S5In& P, int g, int n, float& are, float& aim, float& cr, float& ci) {
    const float lr = P.lam_re[g * NS + n], li = P.lam_im[g * NS + n], dt = expf(P.log_step[g]);
    const float mag = expf(lr * dt); double s, c; sincos_d((double)li * (double)dt, s, c);
    const double ar = (double)mag * c, ai = (double)mag * s;
    are = (float)ar; aim = (float)ai;
    const double nr = ar - 1.0, ni = ai, den = (double)lr * lr + (double)li * li;
    cr = (float)((nr * lr + ni * li) / den); ci = (float)((ni * lr - nr * li) / den);
}
__device__ __forceinline__ void s5_setup(const S5In& P, int g, int lane, float& are, float& aim, float (&bbr)[16], float (&bbi)[16]) {
    float cr, ci; s5_abar(P, g, lane, are, aim, cr, ci);
    const f32x4* br = (const f32x4*)(P.b_re + (size_t)(g * NS + lane) * 16); const f32x4* bi = (const f32x4*)(P.b_im + (size_t)(g * NS + lane) * 16);
#pragma unroll
    for (int q = 0; q < 4; ++q) { const f32x4 r = br[q], i = bi[q];
#pragma unroll
        for (int e = 0; e < 4; ++e) { bbr[q * 4 + e] = cr * r[e] - ci * i[e]; bbi[q * 4 + e] = cr * i[e] + ci * r[e]; } }
}
#define S5_STEP4(uv)                                                                                                     \
    _Pragma("unroll") for (int j = 0; j < 4; ++j) {                                                                      \
        float bur = 0.f, bui = 0.f;                                                                                      \
        _Pragma("unroll") for (int p = 0; p < 16; ++p) { const float up = __int_as_float(__builtin_amdgcn_readlane(__float_as_int(uv), j * 16 + p)); bur = fmaf(up, bbr[p], bur); bui = fmaf(up, bbi[p], bui); } \
        const float nxr = are * xr - aim * xi + bur; xi = are * xi + aim * xr + bui; xr = nxr;                           \
        S5_EMIT(j) }
__device__ __forceinline__ void s5_local_item(const S5In& P, int item, const float* S5U, float* S5E, int lane) {
    const int c = item >> 5, g = item & 31; const int row0 = c == 0 ? MR : 64 * (c - 1), T = c == 0 ? NMETA : 64;
    float are, aim, bbr[16], bbi[16]; s5_setup(P, g, lane, are, aim, bbr, bbi);
    float xr = 0.f, xi = 0.f;
#define S5_EMIT(j)
    float uvs[16];
#pragma unroll
    for (int q = 0; q < 16; ++q) uvs[q] = (4 * q < T) ? S5U[(size_t)(row0 + 4 * q + (lane >> 4)) * S5W + g * 16 + (lane & 15)] : 0.f;
#pragma unroll
    for (int q = 0; q < 16; ++q) { if (4 * q < T) { const float uv = uvs[q]; S5_STEP4(uv) } }
#undef S5_EMIT
    *(float2*)(S5E + ((size_t)c * 2048 + g * NS + lane) * 2) = make_float2(xr, xi);
}
__device__ __forceinline__ float gelu_tanh(float x) { const float u = 0.7978845608028654f * (x + 0.044715f * x * x * x); const float th = 1.0f - 2.0f * __builtin_amdgcn_rcpf(1.0f + __expf(2.0f * u)); return 0.5f * x * (1.0f + th); }
__device__ __forceinline__ void s5_out_item(LAS unsigned char* xs, const S5In& P, int item, const float* S5U, const float* S5E, bf16_t* Z, int lane) {
    const int c = 1 + (item >> 5), g = item & 31, row0 = 64 * (c - 1), lr = lane & 15, lq = lane >> 4;
    float are, aim, bbr[16], bbi[16]; s5_setup(P, g, lane, are, aim, bbr, bbi);
    bf16x8 cf[4];
#pragma unroll
    for (int ks = 0; ks < 4; ++ks) { const float* src = (ks < 2 ? P.c_re : P.c_im) + (size_t)(g * 16 + lr) * NS + (ks & 1) * 32 + 8 * lq; const float sg = ks < 2 ? 1.f : -1.f;
        const f32x4 a = *(const f32x4*)src, b = *(const f32x4*)(src + 4);
        u32x4 w; w.x = cvt_pk_bf16(sg * a.x, sg * a.y); w.y = cvt_pk_bf16(sg * a.z, sg * a.w); w.z = cvt_pk_bf16(sg * b.x, sg * b.y); w.w = cvt_pk_bf16(sg * b.z, sg * b.w);
        cf[ks] = __builtin_bit_cast(bf16x8, w); }
    const f32x4 dk = *(const f32x4*)(P.d + g * 16 + 4 * lq);
    const float2 x0 = *(const float2*)(S5E + ((size_t)c * 2048 + g * NS + lane) * 2);
    float xr = x0.x, xi = x0.y;
    float uvs[16]; f32x4 u4s[4];
#pragma unroll
    for (int q = 0; q < 16; ++q) uvs[q] = S5U[(size_t)(row0 + 4 * q + (lane >> 4)) * S5W + g * 16 + (lane & 15)];
#pragma unroll
    for (int q = 0; q < 4; ++q) u4s[q] = *(const f32x4*)(S5U + (size_t)(row0 + q * 16 + lr) * S5W + g * 16 + 4 * lq);
#pragma unroll
    for (int blk = 0; blk < 4; ++blk) {
#define S5_EMIT(j) { const unsigned pk = cvt_pk_bf16(xr, xi); *(LAS bf16_t*)(xs + (sub * 4 + j) * 272 + lane * 2) = (bf16_t)(pk & 0xffffu); *(LAS bf16_t*)(xs + (sub * 4 + j) * 272 + 128 + lane * 2) = (bf16_t)(pk >> 16); }
#pragma unroll
        for (int sub = 0; sub < 4; ++sub) { const float uv = uvs[blk * 4 + sub]; S5_STEP4(uv) }
#undef S5_EMIT
        LDS_WAIT(); __builtin_amdgcn_wave_barrier();
        f32x4 acc = (f32x4){0.f, 0.f, 0.f, 0.f};
#pragma unroll
        for (int ks = 0; ks < 4; ++ks) { const bf16x8 xf = *(const LAS bf16x8*)(xs + lr * 272 + (ks * 32 + 8 * lq) * 2); acc = __builtin_amdgcn_mfma_f32_16x16x32_bf16(cf[ks], xf, acc, 0, 0, 0); }
        const size_t row = (size_t)(row0 + blk * 16 + lr);
        const f32x4 u4 = u4s[blk];
        u32x2 w; w.x = cvt_pk_bf16(gelu_tanh(acc.x + dk.x * u4.x), gelu_tanh(acc.y + dk.y * u4.y)); w.y = cvt_pk_bf16(gelu_tanh(acc.z + dk.z * u4.z), gelu_tanh(acc.w + dk.w * u4.w));
        *(u32x2*)(Z + row * S5W + g * 16 + 4 * lq) = w;
        LDS_WAIT(); __builtin_amdgcn_wave_barrier();
    }
}

__global__ void __launch_bounds__(512, 2) fwd(Args a) {
    __shared__ __attribute__((aligned(16))) unsigned char lds_raw[LDS_BYTES];
    LAS unsigned char* lds = (LAS unsigned char*)lds_raw;
    const int tid = threadIdx.x, lane = tid & 63, wave = __builtin_amdgcn_readfirstlane(tid >> 6);
    const int G = gridDim.x, bx = blockIdx.x, gw = bx * 8 + wave, NGW = G * 8;
    unsigned char* ws = a.ws;
    const float* x = a.in[0]; const float* meta = a.in[1];
    bf16_t* WGU = (bf16_t*)(ws + WS_WGU); bf16_t* WD = (bf16_t*)(ws + WS_WD); bf16_t* WIN = (bf16_t*)(ws + WS_WIN); bf16_t* WHG = (bf16_t*)(ws + WS_WHG);
    bf16_t* WGLU = (bf16_t*)(ws + WS_WGLU); bf16_t* WOUT = (bf16_t*)(ws + WS_WOUT);
    float* HRES = (float*)(ws + WS_HRES); bf16_t* ABUF = (bf16_t*)(ws + WS_ABUF);
    bf16_t* Qb = (bf16_t*)(ws + WS_Q); bf16_t* Kb = (bf16_t*)(ws + WS_K); float* LOGF = (float*)(ws + WS_LOGF); bf16_t* Vb = (bf16_t*)(ws + WS_V); bf16_t* GS = (bf16_t*)(ws + WS_GS);
    float* S5U = (float*)(ws + WS_S5U); bf16_t* Z = (bf16_t*)(ws + WS_Z); float* PARTA = (float*)(ws + WS_PARTA); float* PARTB = (float*)(ws + WS_PARTB);
    float* DEC = (float*)(ws + WS_DEC); float* S5E = (float*)(ws + WS_S5E); bf16_t* Hh = (bf16_t*)(ws + WS_H); bf16_t* GATES = (bf16_t*)(ws + WS_GATES);
    bf16_t* ST = (bf16_t*)a.out; bf16_t* YS = (bf16_t*)((unsigned char*)a.out + DO_YS); bf16_t* MERGED = (bf16_t*)((unsigned char*)a.out + DO_MERGED);
    S5In s5p{a.in[11], a.in[12], a.in[13], a.in[14], a.in[15], a.in[16], a.in[17], a.in[18]};
    const int lo = a.lo, hi = a.hi;
    cg::grid_group grid = cg::this_grid();
#define IN(k) (lo <= (k) && (k) < hi)
#define SEAM(k) do { if (IN((k) + 1)) grid.sync(); } while (0)
    LAS float* scr = (LAS float*)(lds + wave * 8448);

    if (IN(0)) {
        int it = gw;
        tr_run(TrJob{a.in[3], D, FF, WGU, a.in[2], 1}, it, NGW, scr, lane);
        tr_run(TrJob{a.in[4], D, FF, WGU, a.in[2], 2}, it, NGW, scr, lane);
        tr_run(TrJob{a.in[5], FF, D, WD, nullptr, 0}, it, NGW, scr, lane);
        for (int row = gw; row < MP; row += NGW) {
            const float* src = row < MR ? x + (size_t)row * D : (row < MR + NMETA ? meta + (size_t)(row - MR) * D : nullptr);
            float ss = 0.f;
#pragma unroll
            for (int j = 0; j < 8; ++j) { const f32x4 v = src ? *(const f32x4*)(src + 4 * lane + 256 * j) : (f32x4){0.f, 0.f, 0.f, 0.f};
                ss += (v.x * v.x + v.y * v.y) + (v.z * v.z + v.w * v.w);
                u32x2 w; w.x = cvt_pk_bf16(v.x, v.y); w.y = cvt_pk_bf16(v.z, v.w); *(u32x2*)(ABUF + (size_t)row * D + 4 * lane + 256 * j) = w; }
            ss = wave_sum(ss);
            if (lane < 32) { PARTA[(size_t)row * 32 + lane] = lane == 0 ? ss : 0.f; if (row >= MR) PARTB[(size_t)row * 32 + lane] = 0.f; }
        }
        SEAM(0);
    }
    if (IN(1)) { pg8::Gemm g{ABUF, WGU, MP, 2 * FF, D}; pg8::StaticOrder S; S.init(MP, 2 * FF, G, bx); EpiSwiglu E{Hh, PARTA}; pg8::gemm_phase(lds, g, S, E);
        {
            const int nfull = (MP / 256) * (2 * FF / 256) % G, nfill = nfull ? G - nfull : G;
            if (bx >= nfull || nfull == 0) { const int fb = nfull ? bx - nfull : bx; int it = fb * 8 + wave; const int NW = nfill * 8;
                tr_run(TrJob{a.in[7], D, INCOLS, WIN, a.in[6], 0}, it, NW, scr, lane);
                tr_run(TrJob{a.in[10], HK, D, WHG, nullptr, 0}, it, NW, scr, lane);
                tr_run(TrJob{a.in[19], S5W, D, WGLU, nullptr, 1}, it, NW, scr, lane);
                tr_run(TrJob{a.in[20], S5W, D, WGLU, nullptr, 2}, it, NW, scr, lane);
                tr_run(TrJob{a.in[21], D, D, WOUT, nullptr, 0}, it, NW, scr, lane); }
        }
        SEAM(1); }
    if (IN(2)) { if (bx < D / 16) skinny_down(lds, bx, Hh + (size_t)MR * FF, WD, meta, ABUF, PARTB, wave, lane);
        pg8::Gemm g{Hh, WD, MR, D, FF}; pg8::StaticOrder S; S.init(MR, D, G, bx); EpiRes E{nullptr, x, meta, HRES, ABUF, PARTB, 0.5f, 0}; pg8::gemm_phase(lds, g, S, E); SEAM(2); }
    if (IN(3)) { pg8::Gemm g{ABUF, WIN, MP, NREC, D}; pg8::StaticOrder S; S.init(MP, NREC, G, bx); EpiRec E{Qb, Kb, Vb, GS, LOGF, S5U, PARTB, a.in[8]}; pg8::gemm_phase(lds, g, S, E);
        {
            const int nfull = (MP / 256) * (NREC / 256) % G, nfill = nfull ? G - nfull : G;
            if (bx >= nfull || nfull == 0) { const int fb = nfull ? bx - nfull : bx; int it = fb * 8 + wave; const int NW = nfill * 8;
                tr_run(TrJob{a.in[23], D, FF, WGU, a.in[22], 1}, it, NW, scr, lane);
                tr_run(TrJob{a.in[24], D, FF, WGU, a.in[22], 2}, it, NW, scr, lane);
                tr_run(TrJob{a.in[25], FF, D, WD, nullptr, 0}, it, NW, scr, lane); }
        }
        SEAM(3); }
    if (IN(4)) {
#ifndef DBG_NO_HGL
        for (int item = bx; item < NCH * NH; item += G) hg_local_item(lds, item, LOGF, Kb, Vb, ST, DEC, tid, wave, lane);
#endif
#ifndef DBG_NO_S5L
        for (int item = gw; item < 128 * 32; item += NGW) s5_local_item(s5p, item, S5U, S5E, lane);
#endif
        SEAM(4);
    }
    if (IN(5)) {
        const int gt = bx * 512 + tid;
        if (gt < 98304) {
            unsigned* S32 = (unsigned*)ST; const int e = gt, h = e >> 13, k = (e & 63) * 2;
            float s0 = 0.f, s1 = 0.f;
            for (int cb = 0; cb < 128; cb += 32) {
                unsigned w[32]; float2 d[32];
#pragma unroll
                for (int j = 0; j < 32; ++j) { w[j] = S32[(size_t)(cb + j) * 98304 + e]; d[j] = *(const float2*)(DEC + (size_t)((cb + j) * NH + h) * 128 + k); }
#pragma unroll
                for (int j = 0; j < 32; ++j) { S32[(size_t)(cb + j) * 98304 + e] = cvt_pk_bf16(s0, s1); s0 = fmaf(d[j].x, s0, bf_lo(w[j])); s1 = fmaf(d[j].y, s1, bf_hi(w[j])); }
            }
            S32[(size_t)128 * 98304 + e] = cvt_pk_bf16(s0, s1);
        } else if (gt < 98304 + 2048) {
            const int ch = gt - 98304; float ar, ai, cr, ci; s5_abar(s5p, ch >> 6, ch & 63, ar, ai, cr, ci);
#pragma unroll
            for (int q = 0; q < 6; ++q) { const float nr = ar * ar - ai * ai; ai = 2.f * ar * ai; ar = nr; }
            float xr = 0.f, xi = 0.f;
            for (int cb = 0; cb < 128; cb += 32) {
                float2 ev[32];
#pragma unroll
                for (int j = 0; j < 32; ++j) ev[j] = *(const float2*)(S5E + ((size_t)(cb + j) * 2048 + ch) * 2);
#pragma unroll
                for (int j = 0; j < 32; ++j) { *(float2*)(S5E + ((size_t)(cb + j) * 2048 + ch) * 2) = make_float2(xr, xi);
                    const float nxr = ar * xr - ai * xi + ev[j].x; xi = ar * xi + ai * xr + ev[j].y; xr = nxr; }
            }
            *(float2*)(S5E + ((size_t)128 * 2048 + ch) * 2) = make_float2(xr, xi);
        }
        SEAM(5);
    }
    if (IN(6)) {
        for (int item = bx; item < 128 * NH; item += G) hg_out_item(lds, item, LOGF, Qb, Kb, Vb, ST, GS, a.in[9], tid, wave, lane);
        for (int item = gw; item < 128 * 32; item += NGW) s5_out_item(lds + wave * 4352, s5p, item, S5U, S5E, Z, lane);
        SEAM(6);
    }
    if (IN(7)) { pg8::Gemm g{ABUF, WIN + (size_t)NREC * D, MR, NGATE, D}; pg8::StaticOrder S; S.init(MR, NGATE, G, bx); EpiGates E{GATES, PARTB}; pg8::gemm_phase(lds, g, S, E); SEAM(7); }
    if (IN(8)) { pg8::Gemm g{Z, WGLU, MR, 2 * D, S5W}; pg8::StaticOrder S; S.init(MR, 2 * D, G, bx); EpiGlu E{GATES, YS}; pg8::gemm_phase(lds, g, S, E); SEAM(8); }
    if (IN(9)) { pg8::Gemm g{GS, WHG, MR, D, HK}; pg8::StaticOrder S; S.init(MR, D, G, bx); EpiMerge E{GATES, YS, MERGED}; pg8::gemm_phase(lds, g, S, E); SEAM(9); }
    if (IN(10)) { pg8::Gemm g{MERGED, WOUT, MR, D, D}; pg8::StaticOrder S; S.init(MR, D, G, bx); EpiRes E{HRES, x, meta, HRES, ABUF, PARTA, 1.0f, 1}; pg8::gemm_phase(lds, g, S, E); SEAM(10); }
    if (IN(11)) { pg8::Gemm g{ABUF, WGU, MR, 2 * FF, D}; pg8::StaticOrder S; S.init(MR, 2 * FF, G, bx); EpiSwiglu E{Hh, PARTA}; pg8::gemm_phase(lds, g, S, E); SEAM(11); }
    if (IN(12)) { pg8::Gemm g{Hh, WD, MR, D, FF}; pg8::StaticOrder S; S.init(MR, D, G, bx); EpiRes E{HRES, x, meta, a.out, nullptr, PARTB, 0.5f, 1}; pg8::gemm_phase(lds, g, S, E); SEAM(12); }
    if (IN(13)) {
        const float* gf = a.in[26];
        for (int row = gw; row < MR; row += NGW) {
            const float pv = lane < 32 ? PARTB[(size_t)row * 32 + lane] : 0.f; const float rstd = rsqrtf(wave_sum(pv) * (1.0f / D) + EPS);
            float* o = a.out + (size_t)row * D;
#pragma unroll
            for (int j = 0; j < 8; ++j) { f32x4 v = *(f32x4*)(o + 4 * lane + 256 * j); const f32x4 gg = *(const f32x4*)(gf + 4 * lane + 256 * j);
                v.x *= rstd * gg.x; v.y *= rstd * gg.y; v.z *= rstd * gg.z; v.w *= rstd * gg.w; *(f32x4*)(o + 4 * lane + 256 * j) = v; }
        }
    }
#undef IN
#undef SEAM
}


#ifdef DBG_STOP
struct DbgReg { const unsigned* p; size_t nwords; };
struct DbgArgs { DbgReg r[24]; int n; int pad; unsigned* sums; };
__global__ void dbg_sum(DbgArgs d) {
    for (int i = 0; i < d.n; ++i) { unsigned s = 0; for (size_t w = (size_t)blockIdx.x * blockDim.x + threadIdx.x; w < d.r[i].nwords; w += (size_t)gridDim.x * blockDim.x) s += d.r[i].p[w] * 2654435761u + (unsigned)w;
        for (int o = 1; o < 64; o <<= 1) s += __shfl_xor(s, o);
        if ((threadIdx.x & 63) == 0) atomicAdd(d.sums + i, s); }
}
__global__ void dbg_fill(float* out, const unsigned* sums, int n, size_t total) {
    for (size_t w = (size_t)blockIdx.x * blockDim.x + threadIdx.x; w < total; w += (size_t)gridDim.x * blockDim.x) out[w] = w < (size_t)n ? (float)(sums[w] & 0xFFFFFu) : 0.f;
}
#endif
constexpr int NPHASES = 14;
extern "C" void kernel_launch(void* const* d_in, const int* in_sizes, int n_in, void* d_out, int out_size, void* d_ws, size_t ws_size, hipStream_t stream) {
    static int grid = 0;
    if (grid == 0) {
        if (n_in != 27 || out_size != MR * D || ws_size < WS_END + 256) { fprintf(stderr, "kernel_launch: unexpected shapes (n_in %d out %d ws %zu need %zu)\n", n_in, out_size, ws_size, (size_t)WS_END); grid = -1; return; }
        int dev = 0, cus = 0, per_cu = 0;
        (void)hipGetDevice(&dev); (void)hipDeviceGetAttribute(&cus, hipDeviceAttributeMultiprocessorCount, dev);
        if (hipOccupancyMaxActiveBlocksPerMultiprocessor(&per_cu, (const void*)fwd, 512, 0) != hipSuccess || per_cu < 1) { fprintf(stderr, "kernel_launch: occupancy query gave %d\n", per_cu); per_cu = 1; }
        (void)hipGetLastError();
        grid = cus * 1;
        fprintf(stderr, "kernel_launch: grid %d (cus %d, per_cu %d), ws %zu need %zu\n", grid, cus, per_cu, ws_size, (size_t)WS_END);
    }
    if (grid < 0) return;
    Args a{};
    for (int i = 0; i < 27; ++i) a.in[i] = (const float*)d_in[i];
    a.out = (float*)d_out; a.ws = (unsigned char*)d_ws;
#if MK_MULTI
#ifdef DBG_STOP
    for (int p = 0; p <= DBG_STOP; ++p) { a.lo = p; a.hi = p + 1; hipLaunchKernelGGL(fwd, dim3(grid), dim3(512), 0, stream, a); }
    {
        unsigned char* ws = (unsigned char*)d_ws; DbgArgs d{}; int n = 0;
        auto add = [&](size_t off, size_t bytes) { d.r[n].p = (const unsigned*)(ws + off); d.r[n].nwords = bytes / 4; ++n; };
        const int sel = DBG_SEL;
        if (sel & 1) { add(WS_WGU, (size_t)2 * FF * D * 2); add(WS_WD, (size_t)D * FF * 2); add(WS_WIN, (size_t)INCOLS * D * 2); add(WS_WHG, (size_t)D * HK * 2); add(WS_WGLU, (size_t)2 * D * S5W * 2); add(WS_WOUT, (size_t)D * D * 2); }
        if (sel & 2) { add(WS_HRES, (size_t)MP * D * 4); add(WS_ABUF, (size_t)MP * D * 2); add(WS_PARTB, (size_t)MP * 32 * 4); }
        if (sel & 4) { add(WS_Q, (size_t)MP * HK * 2); add(WS_K, (size_t)MP * HK * 2); add(WS_V, (size_t)MP * HK * 2); add(WS_S5U, (size_t)MP * S5W * 4); }
        if (sel & 8) { add(WS_LOGF, (size_t)(MR + NMETA) * HK * 4); add(WS_DEC, (size_t)128 * NH * 128 * 4); }
        if (sel & 128) { add(WS_S5E, (size_t)128 * 2048 * 8); }
        if (sel & 16) { add(WS_GS, (size_t)MR * HK * 2); add(WS_Z, (size_t)MR * S5W * 2); }
        if (sel & 64) { add(WS_LOGF, (size_t)(MR + NMETA) * HK * 4); add(WS_GS, (size_t)MP * HK * 2); }
        if (sel & 32) { d.r[n].p = (const unsigned*)d_out; d.r[n].nwords = (size_t)128 * NH * 16384 * 2 / 4; ++n; }
        d.n = n; d.sums = (unsigned*)(ws + WS_END);
        hipMemsetAsync(ws + WS_END, 0, 256, stream);
        hipLaunchKernelGGL(dbg_sum, dim3(1024), dim3(256), 0, stream, d);
        hipLaunchKernelGGL(dbg_fill, dim3(1024), dim3(256), 0, stream, (float*)d_out, (const unsigned*)(ws + WS_END), n, (size_t)MR * D);
    }
#else
#ifdef PROBE_SEQ
    { const int seq[] = PROBE_SEQ; for (int i = 0; i < (int)(sizeof(seq) / sizeof(int)); ++i) { a.lo = seq[i]; a.hi = seq[i] + 1; hipLaunchKernelGGL(fwd, dim3(grid), dim3(512), 0, stream, a); } }
#else
    for (int p = 0; p < NPHASES; ++p) { a.lo = p; a.hi = p + 1; hipLaunchKernelGGL(fwd, dim3(grid), dim3(512), 0, stream, a); }
#endif
#endif
#else
    a.lo = 0; a.hi = NPHASES;
    void* args[] = {&a};
    hipError_t e = hipLaunchCooperativeKernel((const void*)fwd, dim3(grid), dim3(512), args, 0, stream);
    if (e != hipSuccess) fprintf(stderr, "kernel_launch: cooperative launch failed: %s (grid %d)\n", hipGetErrorString(e), grid);
#endif
}
```

```cpp
#include <hip/hip_runtime.h>
#include <hip/hip_cooperative_groups.h>
#include <cstdio>
namespace cg = cooperative_groups;

#ifndef MK_MULTI
#define MK_MULTI 0
#endif

namespace pg8 {
#define PG8_LAS __attribute__((address_space(3)))
typedef unsigned short bf16_t;
typedef short bf16x8 __attribute__((ext_vector_type(8)));
typedef float f32x4 __attribute__((ext_vector_type(4)));
typedef unsigned u32x4 __attribute__((ext_vector_type(4)));
typedef unsigned u32x2 __attribute__((ext_vector_type(2)));
constexpr int BM = 256, BK = 64, HALF = 128, HTB = HALF * BK * 2  , STAGE_BYTES = 8 * HTB, NXCD = 8, WGM = 8;

__host__ __device__ __forceinline__ int lds_byte(int r, int c) { const int st = (r >> 4) * 2 + (c >> 5), rr = r & 15, cc = c & 31, ob = rr * 64 + cc * 2; return st * 1024 + (ob ^ (((ob >> 9) & 1) << 5)); }
__host__ __device__ __forceinline__ void stage_rc(int b, int& R, int& C) { const int st = b / 1024, sb = b % 1024, swz = sb ^ (((sb >> 9) & 1) << 5); R = (st >> 1) * 16 + swz / 64; C = (st & 1) * 32 + (swz % 64) / 2; }
__host__ __device__ __forceinline__ int perm32(int rho) { const int n = rho >> 4, i = rho & 15; return 8 * (i >> 2) + 4 * n + (i & 3); }

struct Unit { int pm, pn; };
struct Gemm { const bf16_t* A; const bf16_t* Bt; int M, N, K; };

struct StaticOrder {
    int nM, nN, nwg, G, c;
    __host__ __device__ void init(int M, int N, int G_, int c_) { nM = M / BM; nN = N / BM; nwg = nM * nN; G = G_; c = c_; }
    __host__ __device__ bool next(int i, Unit& u) const {
        const long L = (long)i * G + c; if (L >= nwg) return false;
        int wgid = (int)L; { const int q = nwg / NXCD, r = nwg % NXCD, xcd = wgid % NXCD, off = wgid / NXCD; wgid = (xcd < r ? xcd * (q + 1) : r * (q + 1) + (xcd - r) * q) + off; }
        const int nig = WGM * nN, gid = wgid / nig, fm = gid * WGM, gsz = (nM - fm) < WGM ? (nM - fm) : WGM;
        u.pm = fm + ((wgid % nig) % gsz); u.pn = (wgid % nig) / gsz; return true;
    }
    __device__ __forceinline__ void a_ready(const Unit&) const {}
    __device__ __forceinline__ void done(const Unit&) const {}
};
typedef float f32x2v __attribute__((ext_vector_type(2)));
typedef __bf16 bf16x2v __attribute__((ext_vector_type(2)));
__device__ __forceinline__ unsigned cvt_pk_bf16(float lo, float hi) { const f32x2v v = {lo, hi}; const bf16x2v b = __builtin_convertvector(v, bf16x2v); return __builtin_bit_cast(unsigned, b); }

template <class Epi, class Sched>
__device__ __forceinline__ void gemm_phase(PG8_LAS unsigned char* lds, const Gemm g, const Sched& S, const Epi& E) {
    const int tid = threadIdx.x, wid = __builtin_amdgcn_readfirstlane(tid >> 6), lane = tid & 63, wr = wid >> 2, wc = wid & 3, fr = lane & 15, fq = lane >> 4;
    const int K = g.K, nt = K / BK;
    unsigned voffA[2], voffB[2];
#pragma unroll
    for (int i = 0; i < 2; ++i) { int R, C; stage_rc(tid * 16 + i * 8192, R, C); const int Rb = Epi::PERM ? ((R & ~31) + perm32(R & 31)) : R;
        voffA[i] = (unsigned)(R * K + C) * 2u; voffB[i] = (unsigned)(Rb * K + C) * 2u; }
    const size_t kstep = (size_t)(BK * 2);
    const size_t hstep = (size_t)HALF * K * 2;
    const size_t tstep = 2 * hstep;
    const unsigned ldsw = (unsigned)wid * 1024u;
    const int aoff = lds_byte(wr * 64 + fr, fq * 8), boff = lds_byte(wc * 32 + fr, fq * 8);
#define PG8_SA(b, h) (((b) * 2 + (h)) * HTB)
#define PG8_SB(b, h) ((4 + (b) * 2 + (h)) * HTB)
#define PG8_STAGE(bufoff, gbase, voff) do { _Pragma("unroll") for (int _i = 0; _i < 2; ++_i) \
        __builtin_amdgcn_global_load_lds((const unsigned*)((const char*)(gbase) + (voff)[_i]), (PG8_LAS unsigned*)(lds + (bufoff) + ldsw + _i * 8192), 16, 0, 0); } while (0)
#define PG8_LDA(dst, b, h) do { _Pragma("unroll") for (int m = 0; m < 4; ++m) _Pragma("unroll") for (int k = 0; k < 2; ++k) dst[m][k] = *(const PG8_LAS bf16x8*)(lds + PG8_SA(b, h) + aoff + m * 2048 + k * 1024); } while (0)
#define PG8_LDB(dst, b, h) do { _Pragma("unroll") for (int n = 0; n < 2; ++n) _Pragma("unroll") for (int k = 0; k < 2; ++k) dst[n][k] = *(const PG8_LAS bf16x8*)(lds + PG8_SB(b, h) + boff + n * 2048 + k * 1024); } while (0)
#define PG8_MMA(ai, bj, At, Bt) do { __builtin_amdgcn_s_setprio(1); _Pragma("unroll") for (int m = 0; m < 4; ++m) _Pragma("unroll") for (int n = 0; n < 2; ++n) _Pragma("unroll") for (int k = 0; k < 2; ++k) \
        acc[ai][bj][m][n] = __builtin_amdgcn_mfma_f32_16x16x32_bf16(Bt[n][k], At[m][k], acc[ai][bj][m][n], 0, 0, 0); __builtin_amdgcn_s_setprio(0); } while (0)
#define PG8_WAIT_V(n) asm volatile("s_waitcnt vmcnt(" #n ")" ::: "memory")
#define PG8_WAIT_L(n) asm volatile("s_waitcnt lgkmcnt(" #n ")" ::: "memory")
#define PG8_BAR __builtin_amdgcn_s_barrier()
#define PG8_SCHED __builtin_amdgcn_sched_barrier(0)
    Unit cur, nxt; int ui = 0;
    if (!S.next(0, cur)) return;
    f32x4 acc[2][2][4][2];
#pragma unroll
    for (int a = 0; a < 2; ++a)
#pragma unroll
        for (int b = 0; b < 2; ++b)
#pragma unroll
            for (int m = 0; m < 4; ++m)
#pragma unroll
                for (int n = 0; n < 2; ++n) acc[a][b][m][n] = (f32x4){0.f, 0.f, 0.f, 0.f};
    bf16x8 At[4][2], B0[2][2], B1[2][2];
    const char* cA = (const char*)g.A + (size_t)cur.pm * tstep; const char* cB = (const char*)g.Bt + (size_t)cur.pn * tstep;
    S.a_ready(cur);
    PG8_STAGE(PG8_SB(0, 0), cB, voffB); PG8_STAGE(PG8_SA(0, 0), cA, voffA); PG8_STAGE(PG8_SB(0, 1), cB + hstep, voffB); PG8_STAGE(PG8_SA(0, 1), cA + hstep, voffA);
    if (wr == 1) PG8_BAR;
    PG8_WAIT_V(4); PG8_BAR;
    PG8_STAGE(PG8_SB(1, 0), cB + kstep, voffB); PG8_STAGE(PG8_SA(1, 0), cA + kstep, voffA); PG8_STAGE(PG8_SB(1, 1), cB + hstep + kstep, voffB);
    PG8_WAIT_V(6); PG8_BAR;
    for (;;) {
        const bool has_next = S.next(ui + 1, nxt);
        const char* nA = has_next ? (const char*)g.A + (size_t)nxt.pm * tstep : cA; const char* nB = has_next ? (const char*)g.Bt + (size_t)nxt.pn * tstep : cB;
        for (int t = 0; t < nt; t += 2) {
            const bool last = (t == nt - 2);
            const char* a1 = cA + (size_t)(t + 1) * kstep;
            const char* a2 = last ? nA : cA + (size_t)(t + 2) * kstep; const char* b2 = last ? nB : cB + (size_t)(t + 2) * kstep;
            const char* a3 = a2 + kstep; const char* b3 = b2 + kstep;
            if (last && has_next) S.a_ready(nxt);
            PG8_LDB(B0, 0, 0); PG8_SCHED; PG8_LDA(At, 0, 0); PG8_STAGE(PG8_SA(1, 1), a1 + hstep, voffA);
            PG8_WAIT_L(8); PG8_BAR; PG8_WAIT_L(0); PG8_MMA(0, 0, At, B0); PG8_BAR; PG8_SCHED;
            PG8_LDB(B1, 0, 1); PG8_STAGE(PG8_SB(0, 0), b2, voffB);
            PG8_BAR; PG8_WAIT_L(0); PG8_MMA(0, 1, At, B1); PG8_BAR;
            PG8_LDA(At, 0, 1); PG8_STAGE(PG8_SA(0, 0), a2, voffA);
            PG8_BAR; PG8_WAIT_L(0); PG8_MMA(1, 0, At, B0); PG8_BAR; PG8_SCHED;
            PG8_STAGE(PG8_SB(0, 1), b2 + hstep, voffB);
            PG8_WAIT_V(6); PG8_BAR; PG8_MMA(1, 1, At, B1); PG8_BAR;
            PG8_LDB(B0, 1, 0); PG8_SCHED; PG8_LDA(At, 1, 0); PG8_STAGE(PG8_SA(0, 1), a2 + hstep, voffA);
            PG8_WAIT_L(8); PG8_BAR; PG8_WAIT_L(0); PG8_MMA(0, 0, At, B0); PG8_BAR; PG8_SCHED;
            PG8_LDB(B1, 1, 1); PG8_STAGE(PG8_SB(1, 0), b3, voffB);
            PG8_BAR; PG8_WAIT_L(0); PG8_MMA(0, 1, At, B1); PG8_BAR;
            PG8_LDA(At, 1, 1); PG8_STAGE(PG8_SA(1, 0), a3, voffA);
            PG8_BAR; PG8_WAIT_L(0); PG8_MMA(1, 0, At, B0); PG8_BAR; PG8_SCHED;
            PG8_STAGE(PG8_SB(1, 1), b3 + hstep, voffB);
            PG8_WAIT_V(6); PG8_BAR; PG8_MMA(1, 1, At, B1); PG8_BAR;
        }
        if constexpr (!Epi::AFTER_DRAIN) { E(acc, cur, wr, wc, fr, fq); S.done(cur); }
        if (!has_next) break;
#pragma unroll
        for (int a = 0; a < 2; ++a)
#pragma unroll
            for (int b = 0; b < 2; ++b)
#pragma unroll
                for (int m = 0; m < 4; ++m)
#pragma unroll
                    for (int n = 0; n < 2; ++n) acc[a][b][m][n] = (f32x4){0.f, 0.f, 0.f, 0.f};
        cur = nxt; cA = nA; cB = nB; ++ui;
    }
    PG8_WAIT_V(0);
    if (wr == 0) PG8_BAR;
    PG8_BAR;
    if constexpr (Epi::AFTER_DRAIN) { E.fused(acc, cur, wr, wc, fr, fq, lds, wid, lane); S.done(cur); }
#undef PG8_SA
#undef PG8_SB
#undef PG8_STAGE
#undef PG8_LDA
#undef PG8_LDB
#undef PG8_MMA
#undef PG8_WAIT_V
#undef PG8_WAIT_L
#undef PG8_BAR
#undef PG8_SCHED
}
}

using pg8::bf16_t; using pg8::bf16x8; using pg8::f32x4; using pg8::u32x4; using pg8::u32x2; using pg8::cvt_pk_bf16;
#define LAS __attribute__((address_space(3)))
constexpr int D = 2048, FF = 5632, MR = 8192, NMETA = 16, MP = 8448;
constexpr int HK = 1536, NH = 12, S5W = 512, NS = 64;
constexpr int NREC = 6656, NGATE = 4096, INCOLS = 10752, NCH = 129;
constexpr float EPS = 1e-6f;
constexpr int LDS_BYTES = 131072;

constexpr size_t WS_WGU  = 0;
constexpr size_t WS_WD   = WS_WGU  + (size_t)2 * FF * D * 2;
constexpr size_t WS_WIN  = WS_WD   + (size_t)D * FF * 2;
constexpr size_t WS_WHG  = WS_WIN  + (size_t)INCOLS * D * 2;
constexpr size_t WS_WGLU = WS_WHG  + (size_t)D * HK * 2;
constexpr size_t WS_WOUT = WS_WGLU + (size_t)2 * D * S5W * 2;
constexpr size_t WS_HRES = WS_WOUT + (size_t)D * D * 2;
constexpr size_t WS_ABUF = WS_HRES + (size_t)MP * D * 4;
constexpr size_t WS_Q    = WS_ABUF + (size_t)MP * D * 2;
constexpr size_t WS_K    = WS_Q    + (size_t)MP * HK * 2;
constexpr size_t WS_LOGF = WS_K    + (size_t)MP * HK * 2;
constexpr size_t WS_V    = WS_LOGF + (size_t)MP * HK * 4;
constexpr size_t WS_GS   = WS_V    + (size_t)MP * HK * 2;
constexpr size_t WS_S5U  = WS_GS   + (size_t)MP * HK * 2;
constexpr size_t WS_Z    = WS_S5U  + (size_t)MP * S5W * 4;
constexpr size_t WS_PARTA= WS_Z    + (size_t)MR * S5W * 2;
constexpr size_t WS_PARTB= WS_PARTA+ (size_t)MP * 32 * 4;
constexpr size_t WS_DEC  = WS_PARTB+ (size_t)MP * 32 * 4;
constexpr size_t WS_S5E  = WS_DEC  + (size_t)128 * NH * 128 * 4;
constexpr size_t WS_END  = WS_S5E  + (size_t)NCH * 2048 * 8;
constexpr size_t WS_H     = WS_Q;
constexpr size_t WS_GATES = WS_Q;
static_assert((size_t)MP * FF * 2 <= WS_V - WS_Q, "H alias");
constexpr size_t DO_YS = 0, DO_MERGED = (size_t)MR * D * 2;

struct Args { const float* in[27]; float* out; unsigned char* ws; int lo, hi; };

__device__ __forceinline__ float bf_lo(unsigned w) { return __uint_as_float(w << 16); }
__device__ __forceinline__ float bf_hi(unsigned w) { return __uint_as_float(w & 0xffff0000u); }
__device__ __forceinline__ float bf2f(bf16_t b) { return __uint_as_float(((unsigned)b) << 16); }
__device__ __forceinline__ float fsigmoid(float x) { return __builtin_amdgcn_rcpf(1.0f + __expf(-x)); }
__device__ __forceinline__ float fsilu(float x) { return x * fsigmoid(x); }
#define LDS_WAIT() asm volatile("s_waitcnt lgkmcnt(0)" ::: "memory")

__device__ __forceinline__ void row_rstd(const float* part, int row0, int fq, float (&rs)[2][4]) {
#pragma unroll
    for (int ai = 0; ai < 2; ++ai)
#pragma unroll
        for (int m = 0; m < 4; ++m) {
            const f32x4* p = (const f32x4*)(part + (size_t)(row0 + ai * 128 + m * 16) * 32 + fq * 8);
            const f32x4 a = p[0], b = p[1];
            float s = ((a.x + a.y) + (a.z + a.w)) + ((b.x + b.y) + (b.z + b.w));
            s += __shfl_xor(s, 16); s += __shfl_xor(s, 32);
            rs[ai][m] = rsqrtf(s * (1.0f / D) + EPS);
        }
}
struct EpiSwiglu {
    static constexpr bool PERM = true, AFTER_DRAIN = false;
    bf16_t* H; const float* part;
    __device__ __forceinline__ void operator()(const f32x4 (&acc)[2][2][4][2], const pg8::Unit& u, int wr, int wc, int fr, int fq) const {
        const int row0 = u.pm * 256 + wr * 64 + fr, col0 = u.pn * 128 + wc * 32 + 8 * fq;
        float rs[2][4]; row_rstd(part, row0, fq, rs);
#pragma unroll
        for (int ai = 0; ai < 2; ++ai)
#pragma unroll
            for (int m = 0; m < 4; ++m) {
                const float r = rs[ai][m]; float h[8];
#pragma unroll
                for (int n = 0; n < 2; ++n)
#pragma unroll
                    for (int j = 0; j < 4; ++j) h[n * 4 + j] = fsilu(acc[ai][0][m][n][j] * r) * (acc[ai][1][m][n][j] * r);
                u32x4 w; w.x = cvt_pk_bf16(h[0], h[1]); w.y = cvt_pk_bf16(h[2], h[3]); w.z = cvt_pk_bf16(h[4], h[5]); w.w = cvt_pk_bf16(h[6], h[7]);
                *(u32x4*)(H + (size_t)(row0 + ai * 128 + m * 16) * FF + col0) = w;
            }
    }
};
struct EpiRes {
    static constexpr bool PERM = false, AFTER_DRAIN = false;
    const float* res; const float* x; const float* meta; float* out; bf16_t* outb; float* part; float alpha; int mode;
    __device__ __forceinline__ void operator()(const f32x4 (&acc)[2][2][4][2], const pg8::Unit& u, int wr, int wc, int fr, int fq) const {
        const int row0 = u.pm * 256 + wr * 64 + fr, col0 = u.pn * 256 + wc * 32 + 4 * fq;
#pragma unroll
        for (int ai = 0; ai < 2; ++ai)
#pragma unroll
            for (int m = 0; m < 4; ++m) {
                const int row = row0 + ai * 128 + m * 16;
                const float* rp = mode ? res + (size_t)row * D : (row < MR ? x + (size_t)row * D : (row < MR + NMETA ? meta + (size_t)(row - MR) * D : nullptr));
                float ss = 0.f;
#pragma unroll
                for (int bj = 0; bj < 2; ++bj)
#pragma unroll
                    for (int n = 0; n < 2; ++n) {
                        const int c = col0 + bj * 128 + n * 16;
                        f32x4 r = rp ? *(const f32x4*)(rp + c) : (f32x4){0.f, 0.f, 0.f, 0.f};
                        const f32x4 o = r + acc[ai][bj][m][n] * alpha;
                        *(f32x4*)(out + (size_t)row * D + c) = o;
                        ss += (o.x * o.x + o.y * o.y) + (o.z * o.z + o.w * o.w);
                        if (outb) { u32x2 w; w.x = cvt_pk_bf16(o.x, o.y); w.y = cvt_pk_bf16(o.z, o.w); *(u32x2*)(outb + (size_t)row * D + c) = w; }
                    }
                ss += __shfl_xor(ss, 16); ss += __shfl_xor(ss, 32);
                if (fq == 0) part[(size_t)row * 32 + u.pn * 4 + wc] = ss;
            }
    }
};
struct EpiRec {
    static constexpr bool PERM = true, AFTER_DRAIN = false;
    bf16_t *Q, *Kb, *V, *GS; float *LOGF, *S5U; const float* part; const float* lbp;
    __device__ __forceinline__ void operator()(const f32x4 (&acc)[2][2][4][2], const pg8::Unit& u, int wr, int wc, int fr, int fq) const {
        const int row0 = u.pm * 256 + wr * 64 + fr, colt = u.pn * 256 + wc * 32 + 8 * fq;
        float rs[2][4]; row_rstd(part, row0, fq, rs);
        const int seg = u.pn < 6 ? 0 : (u.pn < 12 ? 1 : (u.pn < 18 ? 2 : (u.pn < 24 ? 3 : 4)));
#pragma unroll
        for (int bj = 0; bj < 2; ++bj) {
            const int c = colt + bj * 128;
            float lb[8];
            if (seg == 1) {
#pragma unroll
                for (int e = 0; e < 8; ++e) { const float a0 = lbp[c - HK + e], a1 = lbp[HK + c - HK + e]; lb[e] = 1.0f / (1.0f + expf(a1 - a0)); }
            }
#pragma unroll
            for (int ai = 0; ai < 2; ++ai)
#pragma unroll
                for (int m = 0; m < 4; ++m) {
                    const size_t row = (size_t)(row0 + ai * 128 + m * 16); const float r = rs[ai][m];
                    float v[8];
#pragma unroll
                    for (int n = 0; n < 2; ++n)
#pragma unroll
                        for (int j = 0; j < 4; ++j) v[n * 4 + j] = acc[ai][bj][m][n][j] * r;
                    if (seg == 0) {
#pragma unroll
                        for (int e = 0; e < 8; ++e) v[e] = fsilu(v[e]) * 0.08838834764831845f;
                        u32x4 w; w.x = cvt_pk_bf16(v[0], v[1]); w.y = cvt_pk_bf16(v[2], v[3]); w.z = cvt_pk_bf16(v[4], v[5]); w.w = cvt_pk_bf16(v[6], v[7]);
                        *(u32x4*)(Q + row * HK + c) = w;
                    } else if (seg == 1) {
                        float kk[8], lf[8];
#pragma unroll
                        for (int e = 0; e < 8; ++e) { const float sg = 1.0f / (1.0f + __expf(-v[e])); const float f = lb[e] + (1.0f - lb[e]) * sg; kk[e] = 1.0f - f; lf[e] = __logf(f); }
                        u32x4 w; w.x = cvt_pk_bf16(kk[0], kk[1]); w.y = cvt_pk_bf16(kk[2], kk[3]); w.z = cvt_pk_bf16(kk[4], kk[5]); w.w = cvt_pk_bf16(kk[6], kk[7]);
                        *(u32x4*)(Kb + row * HK + (c - HK)) = w;
                        *(f32x4*)(LOGF + row * HK + (c - HK)) = (f32x4){lf[0], lf[1], lf[2], lf[3]};
                        *(f32x4*)(LOGF + row * HK + (c - HK) + 4) = (f32x4){lf[4], lf[5], lf[6], lf[7]};
                    } else if (seg == 2) {
                        u32x4 w; w.x = cvt_pk_bf16(v[0], v[1]); w.y = cvt_pk_bf16(v[2], v[3]); w.z = cvt_pk_bf16(v[4], v[5]); w.w = cvt_pk_bf16(v[6], v[7]);
                        *(u32x4*)(V + row * HK + (c - 2 * HK)) = w;
                    } else if (seg == 3) {
#pragma unroll
                        for (int e = 0; e < 8; ++e) v[e] = fsilu(v[e]);
                        u32x4 w; w.x = cvt_pk_bf16(v[0], v[1]); w.y = cvt_pk_bf16(v[2], v[3]); w.z = cvt_pk_bf16(v[4], v[5]); w.w = cvt_pk_bf16(v[6], v[7]);
                        *(u32x4*)(GS + row * HK + (c - 3 * HK)) = w;
                    } else {
                        *(f32x4*)(S5U + row * S5W + (c - 4 * HK)) = (f32x4){v[0], v[1], v[2], v[3]};
                        *(f32x4*)(S5U + row * S5W + (c - 4 * HK) + 4) = (f32x4){v[4], v[5], v[6], v[7]};
                    }
                }
        }
    }
};
struct EpiGates {
    static constexpr bool PERM = true, AFTER_DRAIN = false;
    bf16_t* G; const float* part;
    __device__ __forceinline__ void operator()(const f32x4 (&acc)[2][2][4][2], const pg8::Unit& u, int wr, int wc, int fr, int fq) const {
        const int row0 = u.pm * 256 + wr * 64 + fr, colt = u.pn * 256 + wc * 32 + 8 * fq;
        float rs[2][4]; row_rstd(part, row0, fq, rs);
#pragma unroll
        for (int ai = 0; ai < 2; ++ai)
#pragma unroll
            for (int m = 0; m < 4; ++m) {
                const float r = rs[ai][m];
#pragma unroll
                for (int bj = 0; bj < 2; ++bj) {
                    float v[8];
#pragma unroll
                    for (int n = 0; n < 2; ++n)
#pragma unroll
                        for (int j = 0; j < 4; ++j) v[n * 4 + j] = fsigmoid(acc[ai][bj][m][n][j] * r);
                    u32x4 w; w.x = cvt_pk_bf16(v[0], v[1]); w.y = cvt_pk_bf16(v[2], v[3]); w.z = cvt_pk_bf16(v[4], v[5]); w.w = cvt_pk_bf16(v[6], v[7]);
                    *(u32x4*)(G + (size_t)(row0 + ai * 128 + m * 16) * NGATE + colt + bj * 128) = w;
                }
            }
    }
};
struct EpiGlu {
    static constexpr bool PERM = true, AFTER_DRAIN = false;
    const bf16_t* G; bf16_t* YS;
    __device__ __forceinline__ void operator()(const f32x4 (&acc)[2][2][4][2], const pg8::Unit& u, int wr, int wc, int fr, int fq) const {
        const int row0 = u.pm * 256 + wr * 64 + fr, col0 = u.pn * 128 + wc * 32 + 8 * fq;
#pragma unroll
        for (int ai = 0; ai < 2; ++ai)
#pragma unroll
            for (int m = 0; m < 4; ++m) {
                const size_t row = (size_t)(row0 + ai * 128 + m * 16);
                const u32x4 gw = *(const u32x4*)(G + row * NGATE + D + col0);
                const float g[8] = {bf_lo(gw.x), bf_hi(gw.x), bf_lo(gw.y), bf_hi(gw.y), bf_lo(gw.z), bf_hi(gw.z), bf_lo(gw.w), bf_hi(gw.w)};
                float y[8];
#pragma unroll
                for (int n = 0; n < 2; ++n)
#pragma unroll
                    for (int j = 0; j < 4; ++j) y[n * 4 + j] = g[n * 4 + j] * acc[ai][0][m][n][j] * fsigmoid(acc[ai][1][m][n][j]);
                u32x4 w; w.x = cvt_pk_bf16(y[0], y[1]); w.y = cvt_pk_bf16(y[2], y[3]); w.z = cvt_pk_bf16(y[4], y[5]); w.w = cvt_pk_bf16(y[6], y[7]);
                *(u32x4*)(YS + row * D + col0) = w;
            }
    }
};
struct EpiMerge {
    static constexpr bool PERM = true, AFTER_DRAIN = false;
    const bf16_t* G; const bf16_t* YS; bf16_t* MG;
    __device__ __forceinline__ void operator()(const f32x4 (&acc)[2][2][4][2], const pg8::Unit& u, int wr, int wc, int fr, int fq) const {
        const int row0 = u.pm * 256 + wr * 64 + fr, colt = u.pn * 256 + wc * 32 + 8 * fq;
#pragma unroll
        for (int ai = 0; ai < 2; ++ai)
#pragma unroll
            for (int m = 0; m < 4; ++m) {
                const size_t row = (size_t)(row0 + ai * 128 + m * 16);
#pragma unroll
                for (int bj = 0; bj < 2; ++bj) {
                    const int c = colt + bj * 128;
                    const u32x4 gw = *(const u32x4*)(G + row * NGATE + c), yw = *(const u32x4*)(YS + row * D + c);
                    const float g[8] = {bf_lo(gw.x), bf_hi(gw.x), bf_lo(gw.y), bf_hi(gw.y), bf_lo(gw.z), bf_hi(gw.z), bf_lo(gw.w), bf_hi(gw.w)};
                    const float y[8] = {bf_lo(yw.x), bf_hi(yw.x), bf_lo(yw.y), bf_hi(yw.y), bf_lo(yw.z), bf_hi(yw.z), bf_lo(yw.w), bf_hi(yw.w)};
                    float o[8];
#pragma unroll
                    for (int n = 0; n < 2; ++n)
#pragma unroll
                        for (int j = 0; j < 4; ++j) o[n * 4 + j] = g[n * 4 + j] * acc[ai][bj][m][n][j] + y[n * 4 + j];
                    u32x4 w; w.x = cvt_pk_bf16(o[0], o[1]); w.y = cvt_pk_bf16(o[2], o[3]); w.z = cvt_pk_bf16(o[4], o[5]); w.w = cvt_pk_bf16(o[6], o[7]);
                    *(u32x4*)(MG + row * D + c) = w;
                }
            }
    }
};

__device__ __forceinline__ float wave_sum(float v) {
#pragma unroll
    for (int o = 1; o < 64; o <<= 1) v += __shfl_xor(v, o);
    return v;
}
__device__ __forceinline__ void tr_item(const float* W, int K, int N, bf16_t* WT, const float* gain, int ilv, LAS float* scr, int item, int lane) {
    const int nblk = N / 32, kb = item / nblk, nb = item - kb * nblk, k0 = 64 * kb, n0 = 32 * nb;
    float wv[32];
    const float* wp = W + (size_t)(k0 + (lane >> 5)) * N + n0 + (lane & 31);
#pragma unroll
    for (int i = 0; i < 32; ++i) wv[i] = __builtin_nontemporal_load(wp + (size_t)(2 * i) * N);
    const float gl = gain ? gain[k0 + lane] : 1.0f;
#pragma unroll
    for (int i = 0; i < 32; ++i) { const float g0 = __int_as_float(__builtin_amdgcn_readlane(__float_as_int(gl), 2 * i)), g1 = __int_as_float(__builtin_amdgcn_readlane(__float_as_int(gl), 2 * i + 1)); scr[(2 * i + (lane >> 5)) * 33 + (lane & 31)] = wv[i] * ((lane >> 5) ? g1 : g0); }
    LDS_WAIT();
    const int c = lane & 7;
#pragma unroll
    for (int j = 0; j < 4; ++j) { const int n = (lane >> 3) + 8 * j; const LAS float* s = scr + (8 * c) * 33 + n;
        u32x4 o; o.x = cvt_pk_bf16(s[0 * 33], s[1 * 33]); o.y = cvt_pk_bf16(s[2 * 33], s[3 * 33]); o.z = cvt_pk_bf16(s[4 * 33], s[5 * 33]); o.w = cvt_pk_bf16(s[6 * 33], s[7 * 33]);
        const int nn = n0 + n; const int drow = ilv ? ((nn >> 7) * 256 + (ilv - 1) * 128 + (nn & 127)) : nn;
        *(u32x4*)(WT + (size_t)drow * K + k0 + 8 * c) = o; }
    LDS_WAIT();
}
struct TrJob { const float* W; int K, N; bf16_t* WT; const float* gain; int ilv; };
__device__ __forceinline__ void tr_run(const TrJob& j, int& it, int NGW, LAS float* scr, int lane) {
    const int n = (j.K / 64) * (j.N / 32);
    for (; it < n; it += NGW) tr_item(j.W, j.K, j.N, j.WT, j.gain, j.ilv, scr, it, lane);
    it -= n;
}

__device__ __forceinline__ void skinny_down(LAS unsigned char* lds, int tile, const bf16_t* Hm, const bf16_t* Wd, const float* meta, bf16_t* ABUF, float* PARTB, int wave, int lane) {
    const int lr = lane & 15, lq = lane >> 4, n0 = 16 * tile, kbase = wave * (FF / 8);
    const bf16_t* ap = Hm + (size_t)lr * FF + kbase + 8 * lq; const bf16_t* bp = Wd + (size_t)(n0 + lr) * FF + kbase + 8 * lq;
    f32x4 acc = (f32x4){0.f, 0.f, 0.f, 0.f};
#pragma unroll 11
    for (int s = 0; s < FF / 8 / 32; ++s) { const bf16x8 af = *(const bf16x8*)(ap + 32 * s), bf = *(const bf16x8*)(bp + 32 * s); acc = __builtin_amdgcn_mfma_f32_16x16x32_bf16(bf, af, acc, 0, 0, 0); }
    *(LAS f32x4*)(lds + (wave * 64 + lane) * 16) = acc;
    __syncthreads();
    if (wave == 0) {
        f32x4 t = (f32x4){0.f, 0.f, 0.f, 0.f};
#pragma unroll
        for (int w = 0; w < 8; ++w) t += *(const LAS f32x4*)(lds + (w * 64 + lane) * 16);
        const int col = n0 + 4 * lq; const f32x4 r = *(const f32x4*)(meta + (size_t)lr * D + col); const f32x4 o = r + t * 0.5f;
        u32x2 w2; w2.x = cvt_pk_bf16(o.x, o.y); w2.y = cvt_pk_bf16(o.z, o.w); *(u32x2*)(ABUF + (size_t)(MR + lr) * D + col) = w2;
        float ss = (o.x * o.x + o.y * o.y) + (o.z * o.z + o.w * o.w); ss += __shfl_xor(ss, 16); ss += __shfl_xor(ss, 32);
        if (lq == 0) atomicAdd(PARTB + (size_t)(MR + lr) * 32 + (tile & 31), ss);
    }
    __syncthreads();
}

constexpr int HG_A1 = 0, HG_A2 = 17408, HG_BK = 34816, HG_ST = 52224, HG_VT = 87040, HG_P = 105472, HG_SSQ = 114688;
constexpr int HL_KT = 0, HL_VT = 18432, HL_QT = 36864;
__device__ __forceinline__ void hg_local_item(LAS unsigned char* lds, int item, float* LOGF, const bf16_t* Kb, const bf16_t* Vb, bf16_t* ST, float* DEC, int tid, int wave, int lane) {
    const int c = item / NH, h = item - c * NH;
    const int row0 = c == 0 ? MR : 64 * (c - 1), T = c == 0 ? NMETA : 64;
    const int kcol = tid & 127, tq = tid >> 7;
    float* LF = LOGF + (size_t)row0 * HK + h * 128 + kcol;
    LAS float* qt = (LAS float*)(lds + HL_QT);
    float cs[16]; float run = 0.f; unsigned kraw[16], vv[16];
    {
        const bf16_t* KP = Kb + (size_t)row0 * HK + h * 128 + kcol; const bf16_t* VP = Vb + (size_t)row0 * HK + h * 128 + kcol;
#pragma unroll
        for (int i = 0; i < 16; ++i) { const int t = tq * 16 + i; const bool ok = t < T; cs[i] = ok ? LF[(size_t)t * HK] : 0.f; kraw[i] = ok ? (unsigned)KP[(size_t)t * HK] : 0u; vv[i] = ok ? (unsigned)VP[(size_t)t * HK] : 0u; }
    }
#pragma unroll
    for (int i = 0; i < 16; ++i) { run += cs[i]; cs[i] = run; }
    qt[tq * 128 + kcol] = run;
    __syncthreads();
    float pre = 0.f, tot = 0.f;
#pragma unroll
    for (int q = 0; q < 4; ++q) { const float x = qt[q * 128 + kcol]; tot += x; if (q < tq) pre += x; }
#pragma unroll
    for (int i = 0; i < 16; ++i) { const int t = tq * 16 + i; cs[i] += pre; if (t < T) LF[(size_t)t * HK] = cs[i]; }
    if (c == NCH - 1) { __syncthreads(); return; }
    {
        float kd[16];
#pragma unroll
        for (int i = 0; i < 16; ++i) kd[i] = __uint_as_float(kraw[i] << 16) * __expf(tot - cs[i]);
        u32x4 a, b;
        a.x = cvt_pk_bf16(kd[0], kd[1]); a.y = cvt_pk_bf16(kd[2], kd[3]); a.z = cvt_pk_bf16(kd[4], kd[5]); a.w = cvt_pk_bf16(kd[6], kd[7]);
        b.x = cvt_pk_bf16(kd[8], kd[9]); b.y = cvt_pk_bf16(kd[10], kd[11]); b.z = cvt_pk_bf16(kd[12], kd[13]); b.w = cvt_pk_bf16(kd[14], kd[15]);
        *(LAS u32x4*)(lds + HL_KT + kcol * 144 + tq * 32) = a; *(LAS u32x4*)(lds + HL_KT + kcol * 144 + tq * 32 + 16) = b;
        a.x = vv[0] | (vv[1] << 16); a.y = vv[2] | (vv[3] << 16); a.z = vv[4] | (vv[5] << 16); a.w = vv[6] | (vv[7] << 16);
        b.x = vv[8] | (vv[9] << 16); b.y = vv[10] | (vv[11] << 16); b.z = vv[12] | (vv[13] << 16); b.w = vv[14] | (vv[15] << 16);
        *(LAS u32x4*)(lds + HL_VT + kcol * 144 + tq * 32) = a; *(LAS u32x4*)(lds + HL_VT + kcol * 144 + tq * 32 + 16) = b;
        if (tq == 0) DEC[(size_t)(c * NH + h) * 128 + kcol] = __expf(tot);
    }
    __syncthreads();
    {
        const int vt0 = (wave >> 1) * 2, kt0 = (wave & 1) * 4, lr = lane & 15, lq = lane >> 4;
        f32x4 acc[2][4];
#pragma unroll
        for (int a = 0; a < 2; ++a)
#pragma unroll
            for (int b = 0; b < 4; ++b) acc[a][b] = (f32x4){0.f, 0.f, 0.f, 0.f};
#pragma unroll
        for (int ks = 0; ks < 2; ++ks) {
            bf16x8 vf[2], kf[4];
#pragma unroll
            for (int a = 0; a < 2; ++a) vf[a] = *(const LAS bf16x8*)(lds + HL_VT + (16 * (vt0 + a) + lr) * 144 + (ks * 32 + 8 * lq) * 2);
#pragma unroll
            for (int b = 0; b < 4; ++b) kf[b] = *(const LAS bf16x8*)(lds + HL_KT + (16 * (kt0 + b) + lr) * 144 + (ks * 32 + 8 * lq) * 2);
#pragma unroll
            for (int a = 0; a < 2; ++a)
#pragma unroll
                for (int b = 0; b < 4; ++b) acc[a][b] = __builtin_amdgcn_mfma_f32_16x16x32_bf16(kf[b], vf[a], acc[a][b], 0, 0, 0);
        }
        bf16_t* dst = ST + (size_t)(c * NH + h) * 16384;
#pragma unroll
        for (int a = 0; a < 2; ++a)
#pragma unroll
            for (int b = 0; b < 4; ++b) { const int v = 16 * (vt0 + a) + lr, k = 16 * (kt0 + b) + 4 * lq;
                u32x2 w; w.x = cvt_pk_bf16(acc[a][b].x, acc[a][b].y); w.y = cvt_pk_bf16(acc[a][b].z, acc[a][b].w);
                *(u32x2*)(dst + v * 128 + k) = w; }
    }
    __syncthreads();
}
__device__ __forceinline__ void hg_out_item(LAS unsigned char* lds, int item, const float* B, const bf16_t* Q, const bf16_t* Kb, const bf16_t* Vb, const bf16_t* ST, bf16_t* GS, const float* hg_norm, int tid, int wave, int lane) {
    const int c = 1 + item / NH, h = item % NH, row0 = 64 * (c - 1);
    u32x2 gpre[4];
#pragma unroll
    for (int tt = 0; tt < 4; ++tt) gpre[tt] = *(const u32x2*)(GS + (size_t)(row0 + 16 * tt + (lane & 15)) * HK + h * 128 + 16 * wave + 4 * (lane >> 4));
#pragma unroll
    for (int jj = 0; jj < 2; ++jj) {
        const int p = tid + 512 * jj, t = p >> 4, k0 = 8 * (p & 15);
        const size_t off = (size_t)(row0 + t) * HK + h * 128 + k0, roff = (size_t)(row0 + 31) * HK + h * 128 + k0;
        const f32x4 b0 = *(const f32x4*)(B + off), b1 = *(const f32x4*)(B + off + 4), r0 = *(const f32x4*)(B + roff), r1 = *(const f32x4*)(B + roff + 4);
        const u32x4 qw = *(const u32x4*)(Q + off), kw = *(const u32x4*)(Kb + off);
        const float bb[8] = {b0.x, b0.y, b0.z, b0.w, b1.x, b1.y, b1.z, b1.w}, rr[8] = {r0.x, r0.y, r0.z, r0.w, r1.x, r1.y, r1.z, r1.w};
        const float qq[8] = {bf_lo(qw.x), bf_hi(qw.x), bf_lo(qw.y), bf_hi(qw.y), bf_lo(qw.z), bf_hi(qw.z), bf_lo(qw.w), bf_hi(qw.w)};
        const float kk[8] = {bf_lo(kw.x), bf_hi(kw.x), bf_lo(kw.y), bf_hi(kw.y), bf_lo(kw.z), bf_hi(kw.z), bf_lo(kw.w), bf_hi(kw.w)};
        float a1[8], a2[8], bk[8];
#pragma unroll
        for (int e = 0; e < 8; ++e) { a1[e] = qq[e] * __expf(bb[e]); a2[e] = qq[e] * __expf(bb[e] - rr[e]); bk[e] = kk[e] * __expf(rr[e] - bb[e]); }
        u32x4 w;
        w.x = cvt_pk_bf16(a1[0], a1[1]); w.y = cvt_pk_bf16(a1[2], a1[3]); w.z = cvt_pk_bf16(a1[4], a1[5]); w.w = cvt_pk_bf16(a1[6], a1[7]); *(LAS u32x4*)(lds + HG_A1 + t * 272 + k0 * 2) = w;
        w.x = cvt_pk_bf16(a2[0], a2[1]); w.y = cvt_pk_bf16(a2[2], a2[3]); w.z = cvt_pk_bf16(a2[4], a2[5]); w.w = cvt_pk_bf16(a2[6], a2[7]); *(LAS u32x4*)(lds + HG_A2 + t * 272 + k0 * 2) = w;
        w.x = cvt_pk_bf16(bk[0], bk[1]); w.y = cvt_pk_bf16(bk[2], bk[3]); w.z = cvt_pk_bf16(bk[4], bk[5]); w.w = cvt_pk_bf16(bk[6], bk[7]); *(LAS u32x4*)(lds + HG_BK + t * 272 + k0 * 2) = w;
    }
    {
        const int vcol = tid & 127, tq = tid >> 7; const bf16_t* VP = Vb + (size_t)(row0 + tq * 16) * HK + h * 128 + vcol; unsigned vv[16];
#pragma unroll
        for (int i = 0; i < 16; ++i) vv[i] = (unsigned)VP[(size_t)i * HK];
        u32x4 a, b;
        a.x = vv[0] | (vv[1] << 16); a.y = vv[2] | (vv[3] << 16); a.z = vv[4] | (vv[5] << 16); a.w = vv[6] | (vv[7] << 16);
        b.x = vv[8] | (vv[9] << 16); b.y = vv[10] | (vv[11] << 16); b.z = vv[12] | (vv[13] << 16); b.w = vv[14] | (vv[15] << 16);
        *(LAS u32x4*)(lds + HG_VT + vcol * 144 + tq * 32) = a; *(LAS u32x4*)(lds + HG_VT + vcol * 144 + tq * 32 + 16) = b;
    }
    {
        const u32x4* src = (const u32x4*)(ST + (size_t)(c * NH + h) * 16384);
#pragma unroll
        for (int jj = 0; jj < 4; ++jj) { const int idx = tid + 512 * jj; *(LAS u32x4*)(lds + HG_ST + (idx >> 4) * 272 + (idx & 15) * 16) = src[idx]; }
    }
    __syncthreads();
    const int lr = lane & 15, lq = lane >> 4;
    {
        const int tt = wave >> 1;
#pragma unroll
        for (int sh = 0; sh < 2; ++sh) {
            const int ss = 2 * (wave & 1) + sh;
            f32x4 acc = (f32x4){0.f, 0.f, 0.f, 0.f};
            if (ss <= tt) {
#pragma unroll
                for (int ks = 0; ks < 4; ++ks) {
                    const bf16x8 af = *(const LAS bf16x8*)(lds + HG_A2 + (16 * tt + lr) * 272 + (ks * 32 + 8 * lq) * 2);
                    const bf16x8 bf = *(const LAS bf16x8*)(lds + HG_BK + (16 * ss + lr) * 272 + (ks * 32 + 8 * lq) * 2);
                    acc = __builtin_amdgcn_mfma_f32_16x16x32_bf16(bf, af, acc, 0, 0, 0);
                }
            }
            const int t = 16 * tt + lr, s0 = 16 * ss + 4 * lq;
            float pv[4];
#pragma unroll
            for (int r = 0; r < 4; ++r) pv[r] = (s0 + r <= t) ? acc[r] : 0.f;
            u32x2 w; w.x = cvt_pk_bf16(pv[0], pv[1]); w.y = cvt_pk_bf16(pv[2], pv[3]);
            *(LAS u32x2*)(lds + HG_P + t * 144 + s0 * 2) = w;
        }
    }
    __syncthreads();
    f32x4 acc[4];
#pragma unroll
    for (int tt = 0; tt < 4; ++tt) acc[tt] = (f32x4){0.f, 0.f, 0.f, 0.f};
#pragma unroll
    for (int ks = 0; ks < 4; ++ks) {
        const bf16x8 sf = *(const LAS bf16x8*)(lds + HG_ST + (16 * wave + lr) * 272 + (ks * 32 + 8 * lq) * 2);
#pragma unroll
        for (int tt = 0; tt < 4; ++tt) { const bf16x8 af = *(const LAS bf16x8*)(lds + HG_A1 + (16 * tt + lr) * 272 + (ks * 32 + 8 * lq) * 2);
            acc[tt] = __builtin_amdgcn_mfma_f32_16x16x32_bf16(sf, af, acc[tt], 0, 0, 0); }
    }
#pragma unroll
    for (int ks = 0; ks < 2; ++ks) {
        const bf16x8 vf = *(const LAS bf16x8*)(lds + HG_VT + (16 * wave + lr) * 144 + (ks * 32 + 8 * lq) * 2);
#pragma unroll
        for (int tt = 0; tt < 4; ++tt) { const bf16x8 pf = *(const LAS bf16x8*)(lds + HG_P + (16 * tt + lr) * 144 + (ks * 32 + 8 * lq) * 2);
            acc[tt] = __builtin_amdgcn_mfma_f32_16x16x32_bf16(vf, pf, acc[tt], 0, 0, 0); }
    }
    LAS float* ssq = (LAS float*)(lds + HG_SSQ);
#pragma unroll
    for (int tt = 0; tt < 4; ++tt) { float s = (acc[tt].x * acc[tt].x + acc[tt].y * acc[tt].y) + (acc[tt].z * acc[tt].z + acc[tt].w * acc[tt].w);
        s += __shfl_xor(s, 16); s += __shfl_xor(s, 32); if (lq == 0) ssq[wave * 64 + 16 * tt + lr] = s; }
    __syncthreads();
    {
        const int col = h * 128 + 16 * wave + 4 * lq; const f32x4 hn = *(const f32x4*)(hg_norm + col);
#pragma unroll
        for (int tt = 0; tt < 4; ++tt) { const int t = 16 * tt + lr; float tot = 0.f;
#pragma unroll
            for (int w8 = 0; w8 < 8; ++w8) tot += ssq[w8 * 64 + t];
            const float rinv = rsqrtf(tot * (1.0f / 128.0f) + EPS);
            bf16_t* gp = GS + (size_t)(row0 + t) * HK + col; const u32x2 gw = gpre[tt];
            u32x2 w; w.x = cvt_pk_bf16(acc[tt].x * rinv * hn.x * bf_lo(gw.x), acc[tt].y * rinv * hn.y * bf_hi(gw.x));
            w.y = cvt_pk_bf16(acc[tt].z * rinv * hn.z * bf_lo(gw.y), acc[tt].w * rinv * hn.w * bf_hi(gw.y));
            *(u32x2*)gp = w; }
    }
    __syncthreads();
}

__device__ __forceinline__ void sincos_d(double x, double& s, double& c) {
    const double kq = rint(x * 0.63661977236758134308);
    double r = fma(-kq, 1.57079632679489655800, x); r = fma(-kq, 6.12323399573676603587e-17, r);
    const double r2 = r * r;
    double sp = 1.0 / 6227020800.0; sp = fma(sp, r2, -1.0 / 39916800.0); sp = fma(sp, r2, 1.0 / 362880.0); sp = fma(sp, r2, -1.0 / 5040.0); sp = fma(sp, r2, 1.0 / 120.0); sp = fma(sp, r2, -1.0 / 6.0); sp = fma(sp * r2, r, r);
    double cp = -1.0 / 87178291200.0; cp = fma(cp, r2, 1.0 / 479001600.0); cp = fma(cp, r2, -1.0 / 3628800.0); cp = fma(cp, r2, 1.0 / 40320.0); cp = fma(cp, r2, -1.0 / 720.0); cp = fma(cp, r2, 1.0 / 24.0); cp = fma(cp, r2, -0.5); cp = fma(cp, r2, 1.0);
    const int q = ((int)kq) & 3;
    s = (q == 0) ? sp : (q == 1) ? cp : (q == 2) ? -sp : -cp;
    c = (q == 0) ? cp : (q == 1) ? -sp : (q == 2) ? -cp : sp;
}
struct S5In { const float *lam_re, *lam_im, *log_step, *b_re, *b_im, *c_re, *c_im, *d; };
__device__ __forceinline__ void s5_abar(const S5In& P, int g, int n, float& are, float& aim, float& cr, float& ci) {
    const float lr = P.lam_re[g * NS + n], li = P.lam_im[g * NS + n], dt = expf(P.log_step[g]);
    const float mag = expf(lr * dt); double s, c; sincos_d((double)li * (double)dt, s, c);
    const double ar = (double)mag * c, ai = (double)mag * s;
    are = (float)ar; aim = (float)ai;
    const double nr = ar - 1.0, ni = ai, den = (double)lr * lr + (double)li * li;
    cr = (float)((nr * lr + ni * li) / den); ci = (float)((ni * lr - nr * li) / den);
}
__device__ __forceinline__ void s5_setup(const S5In& P, int g, int lane, float& are, float& aim, float (&bbr)[16], float (&bbi)[16]) {
    float cr, ci; s5_abar(P, g, lane, are, aim, cr, ci);
    const f32x4* br = (const f32x4*)(P.b_re + (size_t)(g * NS + lane) * 16); const f32x4* bi = (const f32x4*)(P.b_im + (size_t)(g * NS + lane) * 16);
#pragma unroll
    for (int q = 0; q < 4; ++q) { const f32x4 r = br[q], i = bi[q];
#pragma unroll
        for (int e = 0; e < 4; ++e) { bbr[q * 4 + e] = cr * r[e] - ci * i[e]; bbi[q * 4 + e] = cr * i[e] + ci * r[e]; } }
}
#define S5_STEP4(uv)                                                                                                     \
    _Pragma("unroll") for (int j = 0; j < 4; ++j) {                                                                      \
        float bur = 0.f, bui = 0.f;                                                                                      \
        _Pragma("unroll") for (int p = 0; p < 16; ++p) { const float up = __int_as_float(__builtin_amdgcn_readlane(__float_as_int(uv), j * 16 + p)); bur = fmaf(up, bbr[p], bur); bui = fmaf(up, bbi[p], bui); } \
        const float nxr = are * xr - aim * xi + bur; xi = are * xi + aim * xr + bui; xr = nxr;                           \
        S5_EMIT(j) }
__device__ __forceinline__ void s5_local_item(const S5In& P, int item, const float* S5U, float* S5E, int lane) {
    const int c = item >> 5, g = item & 31; const int row0 = c == 0 ? MR : 64 * (c - 1), T = c == 0 ? NMETA : 64;
    float are, aim, bbr[16], bbi[16]; s5_setup(P, g, lane, are, aim, bbr, bbi);
    float xr = 0.f, xi = 0.f;
#define S5_EMIT(j)
    float uvs[16];
#pragma unroll
    for (int q = 0; q < 16; ++q) uvs[q] = (4 * q < T) ? S5U[(size_t)(row0 + 4 * q + (lane >> 4)) * S5W + g * 16 + (lane & 15)] : 0.f;
#pragma unroll
    for (int q = 0; q < 16; ++q) { if (4 * q < T) { const float uv = uvs[q]; S5_STEP4(uv) } }
#undef S5_EMIT
    *(float2*)(S5E + ((size_t)c * 2048 + g * NS + lane) * 2) = make_float2(xr, xi);
}
__device__ __forceinline__ float gelu_tanh(float x) { const float u = 0.7978845608028654f * (x + 0.044715f * x * x * x); const float th = 1.0f - 2.0f * __builtin_amdgcn_rcpf(1.0f + __expf(2.0f * u)); return 0.5f * x * (1.0f + th); }
__device__ __forceinline__ void s5_out_item(LAS unsigned char* xs, const S5In& P, int item, const float* S5U, const float* S5E, bf16_t* Z, int lane) {
    const int c = 1 + (item >> 5), g = item & 31, row0 = 64 * (c - 1), lr = lane & 15, lq = lane >> 4;
    float are, aim, bbr[16], bbi[16]; s5_setup(P, g, lane, are, aim, bbr, bbi);
    bf16x8 cf[4];
#pragma unroll
    for (int ks = 0; ks < 4; ++ks) { const float* src = (ks < 2 ? P.c_re : P.c_im) + (size_t)(g * 16 + lr) * NS + (ks & 1) * 32 + 8 * lq; const float sg = ks < 2 ? 1.f : -1.f;
        const f32x4 a = *(const f32x4*)src, b = *(const f32x4*)(src + 4);
        u32x4 w; w.x = cvt_pk_bf16(sg * a.x, sg * a.y); w.y = cvt_pk_bf16(sg * a.z, sg * a.w); w.z = cvt_pk_bf16(sg * b.x, sg * b.y); w.w = cvt_pk_bf16(sg * b.z, sg * b.w);
        cf[ks] = __builtin_bit_cast(bf16x8, w); }
    const f32x4 dk = *(const f32x4*)(P.d + g * 16 + 4 * lq);
    const float2 x0 = *(const float2*)(S5E + ((size_t)c * 2048 + g * NS + lane) * 2);
    float xr = x0.x, xi = x0.y;
    float uvs[16]; f32x4 u4s[4];
#pragma unroll
    for (int q = 0; q < 16; ++q) uvs[q] = S5U[(size_t)(row0 + 4 * q + (lane >> 4)) * S5W + g * 16 + (lane & 15)];
#pragma unroll
    for (int q = 0; q < 4; ++q) u4s[q] = *(const f32x4*)(S5U + (size_t)(row0 + q * 16 + lr) * S5W + g * 16 + 4 * lq);
#pragma unroll
    for (int blk = 0; blk < 4; ++blk) {
#define S5_EMIT(j) { const unsigned pk = cvt_pk_bf16(xr, xi); *(LAS bf16_t*)(xs + (sub * 4 + j) * 272 + lane * 2) = (bf16_t)(pk & 0xffffu); *(LAS bf16_t*)(xs + (sub * 4 + j) * 272 + 128 + lane * 2) = (bf16_t)(pk >> 16); }
#pragma unroll
        for (int sub = 0; sub < 4; ++sub) { const float uv = uvs[blk * 4 + sub]; S5_STEP4(uv) }
#undef S5_EMIT
        LDS_WAIT(); __builtin_amdgcn_wave_barrier();
        f32x4 acc = (f32x4){0.f, 0.f, 0.f, 0.f};
#pragma unroll
        for (int ks = 0; ks < 4; ++ks) { const bf16x8 xf = *(const LAS bf16x8*)(xs + lr * 272 + (ks * 32 + 8 * lq) * 2); acc = __builtin_amdgcn_mfma_f32_16x16x32_bf16(cf[ks], xf, acc, 0, 0, 0); }
        const size_t row = (size_t)(row0 + blk * 16 + lr);
        const f32x4 u4 = u4s[blk];
        u32x2 w; w.x = cvt_pk_bf16(gelu_tanh(acc.x + dk.x * u4.x), gelu_tanh(acc.y + dk.y * u4.y)); w.y = cvt_pk_bf16(gelu_tanh(acc.z + dk.z * u4.z), gelu_tanh(acc.w + dk.w * u4.w));
        *(u32x2*)(Z + row * S5W + g * 16 + 4 * lq) = w;
        LDS_WAIT(); __builtin_amdgcn_wave_barrier();
    }
}

__global__ void __launch_bounds__(512, 2) fwd(Args a) {
    __shared__ __attribute__((aligned(16))) unsigned char lds_raw[LDS_BYTES];
    LAS unsigned char* lds = (LAS unsigned char*)lds_raw;
    const int tid = threadIdx.x, lane = tid & 63, wave = __builtin_amdgcn_readfirstlane(tid >> 6);
    const int G = gridDim.x, bx = blockIdx.x, gw = bx * 8 + wave, NGW = G * 8;
    unsigned char* ws = a.ws;
    const float* x = a.in[0]; const float* meta = a.in[1];
    bf16_t* WGU = (bf16_t*)(ws + WS_WGU); bf16_t* WD = (bf16_t*)(ws + WS_WD); bf16_t* WIN = (bf16_t*)(ws + WS_WIN); bf16_t* WHG = (bf16_t*)(ws + WS_WHG);
    bf16_t* WGLU = (bf16_t*)(ws + WS_WGLU); bf16_t* WOUT = (bf16_t*)(ws + WS_WOUT);
    float* HRES = (float*)(ws + WS_HRES); bf16_t* ABUF = (bf16_t*)(ws + WS_ABUF);
    bf16_t* Qb = (bf16_t*)(ws + WS_Q); bf16_t* Kb = (bf16_t*)(ws + WS_K); float* LOGF = (float*)(ws + WS_LOGF); bf16_t* Vb = (bf16_t*)(ws + WS_V); bf16_t* GS = (bf16_t*)(ws + WS_GS);
    float* S5U = (float*)(ws + WS_S5U); bf16_t* Z = (bf16_t*)(ws + WS_Z); float* PARTA = (float*)(ws + WS_PARTA); float* PARTB = (float*)(ws + WS_PARTB);
    float* DEC = (float*)(ws + WS_DEC); float* S5E = (float*)(ws + WS_S5E); bf16_t* Hh = (bf16_t*)(ws + WS_H); bf16_t* GATES = (bf16_t*)(ws + WS_GATES);
    bf16_t* ST = (bf16_t*)a.out; bf16_t* YS = (bf16_t*)((unsigned char*)a.out + DO_YS); bf16_t* MERGED = (bf16_t*)((unsigned char*)a.out + DO_MERGED);
    S5In s5p{a.in[11], a.in[12], a.in[13], a.in[14], a.in[15], a.in[16], a.in[17], a.in[18]};
    const int lo = a.lo, hi = a.hi;
    cg::grid_group grid = cg::this_grid();
#define IN(k) (lo <= (k) && (k) < hi)
#define SEAM(k) do { if (IN((k) + 1)) grid.sync(); } while (0)
    LAS float* scr = (LAS float*)(lds + wave * 8448);

    if (IN(0)) {
        int it = gw;
        tr_run(TrJob{a.in[3], D, FF, WGU, a.in[2], 1}, it, NGW, scr, lane);
        tr_run(TrJob{a.in[4], D, FF, WGU, a.in[2], 2}, it, NGW, scr, lane);
        tr_run(TrJob{a.in[5], FF, D, WD, nullptr, 0}, it, NGW, scr, lane);
        for (int row = gw; row < MP; row += NGW) {
            const float* src = row < MR ? x + (size_t)row * D : (row < MR + NMETA ? meta + (size_t)(row - MR) * D : nullptr);
            float ss = 0.f;
#pragma unroll
            for (int j = 0; j < 8; ++j) { const f32x4 v = src ? *(const f32x4*)(src + 4 * lane + 256 * j) : (f32x4){0.f, 0.f, 0.f, 0.f};
                ss += (v.x * v.x + v.y * v.y) + (v.z * v.z + v.w * v.w);
                u32x2 w; w.x = cvt_pk_bf16(v.x, v.y); w.y = cvt_pk_bf16(v.z, v.w); *(u32x2*)(ABUF + (size_t)row * D + 4 * lane + 256 * j) = w; }
            ss = wave_sum(ss);
            if (lane < 32) { PARTA[(size_t)row * 32 + lane] = lane == 0 ? ss : 0.f; if (row >= MR) PARTB[(size_t)row * 32 + lane] = 0.f; }
        }
        SEAM(0);
    }
    if (IN(1)) { pg8::Gemm g{ABUF, WGU, MP, 2 * FF, D}; pg8::StaticOrder S; S.init(MP, 2 * FF, G, bx); EpiSwiglu E{Hh, PARTA}; pg8::gemm_phase(lds, g, S, E);
        {
            const int nfull = (MP / 256) * (2 * FF / 256) % G, nfill = nfull ? G - nfull : G;
            if (bx >= nfull || nfull == 0) { const int fb = nfull ? bx - nfull : bx; int it = fb * 8 + wave; const int NW = nfill * 8;
                tr_run(TrJob{a.in[7], D, INCOLS, WIN, a.in[6], 0}, it, NW, scr, lane); }
        }
        SEAM(1); }
    if (IN(2)) { if (bx < D / 16) skinny_down(lds, bx, Hh + (size_t)MR * FF, WD, meta, ABUF, PARTB, wave, lane);
        pg8::Gemm g{Hh, WD, MR, D, FF}; pg8::StaticOrder S; S.init(MR, D, G, bx); EpiRes E{nullptr, x, meta, HRES, ABUF, PARTB, 0.5f, 0}; pg8::gemm_phase(lds, g, S, E); SEAM(2); }
    if (IN(3)) { pg8::Gemm g{ABUF, WIN, MP, NREC, D}; pg8::StaticOrder S; S.init(MP, NREC, G, bx); EpiRec E{Qb, Kb, Vb, GS, LOGF, S5U, PARTB, a.in[8]}; pg8::gemm_phase(lds, g, S, E);
        {
            const int nfull = (MP / 256) * (NREC / 256) % G, nfill = nfull ? G - nfull : G;
            if (bx >= nfull || nfull == 0) { const int fb = nfull ? bx - nfull : bx; int it = fb * 8 + wave; const int NW = nfill * 8;
                tr_run(TrJob{a.in[23], D, FF, WGU, a.in[22], 1}, it, NW, scr, lane);
                tr_run(TrJob{a.in[24], D, FF, WGU, a.in[22], 2}, it, NW, scr, lane);
                tr_run(TrJob{a.in[25], FF, D, WD, nullptr, 0}, it, NW, scr, lane);
                tr_run(TrJob{a.in[10], HK, D, WHG, nullptr, 0}, it, NW, scr, lane);
                tr_run(TrJob{a.in[19], S5W, D, WGLU, nullptr, 1}, it, NW, scr, lane);
                tr_run(TrJob{a.in[20], S5W, D, WGLU, nullptr, 2}, it, NW, scr, lane);
                tr_run(TrJob{a.in[21], D, D, WOUT, nullptr, 0}, it, NW, scr, lane); }
        }
        SEAM(3); }
    if (IN(4)) {
#ifndef DBG_NO_HGL
        for (int item = bx; item < NCH * NH; item += G) hg_local_item(lds, item, LOGF, Kb, Vb, ST, DEC, tid, wave, lane);
#endif
#ifndef DBG_NO_S5L
        for (int item = gw; item < 128 * 32; item += NGW) s5_local_item(s5p, item, S5U, S5E, lane);
#endif
        SEAM(4);
    }
    if (IN(5)) {
        const int gt = bx * 512 + tid;
        if (gt < 98304) {
            unsigned* S32 = (unsigned*)ST; const int e = gt, h = e >> 13, k = (e & 63) * 2;
            float s0 = 0.f, s1 = 0.f;
            for (int cb = 0; cb < 128; cb += 32) {
                unsigned w[32]; float2 d[32];
#pragma unroll
                for (int j = 0; j < 32; ++j) { w[j] = S32[(size_t)(cb + j) * 98304 + e]; d[j] = *(const float2*)(DEC + (size_t)((cb + j) * NH + h) * 128 + k); }
#pragma unroll
                for (int j = 0; j < 32; ++j) { S32[(size_t)(cb + j) * 98304 + e] = cvt_pk_bf16(s0, s1); s0 = fmaf(d[j].x, s0, bf_lo(w[j])); s1 = fmaf(d[j].y, s1, bf_hi(w[j])); }
            }
            S32[(size_t)128 * 98304 + e] = cvt_pk_bf16(s0, s1);
        } else if (gt < 98304 + 2048) {
            const int ch = gt - 98304; float ar, ai, cr, ci; s5_abar(s5p, ch >> 6, ch & 63, ar, ai, cr, ci);
#pragma unroll
            for (int q = 0; q < 6; ++q) { const float nr = ar * ar - ai * ai; ai = 2.f * ar * ai; ar = nr; }
            float xr = 0.f, xi = 0.f;
            for (int cb = 0; cb < 128; cb += 32) {
                float2 ev[32];
#pragma unroll
                for (int j = 0; j < 32; ++j) ev[j] = *(const float2*)(S5E + ((size_t)(cb + j) * 2048 + ch) * 2);
#pragma unroll
                for (int j = 0; j < 32; ++j) { *(float2*)(S5E + ((size_t)(cb + j) * 2048 + ch) * 2) = make_float2(xr, xi);
                    const float nxr = ar * xr - ai * xi + ev[j].x; xi = ar * xi + ai * xr + ev[j].y; xr = nxr; }
            }
            *(float2*)(S5E + ((size_t)128 * 2048 + ch) * 2) = make_float2(xr, xi);
        }
        SEAM(5);
    }
    if (IN(6)) {
        for (int item = bx; item < 128 * NH; item += G) hg_out_item(lds, item, LOGF, Qb, Kb, Vb, ST, GS, a.in[9], tid, wave, lane);
        for (int item = gw; item < 128 * 32; item += NGW) s5_out_item(lds + wave * 4352, s5p, item, S5U, S5E, Z, lane);
        SEAM(6);
    }
    if (IN(7)) { pg8::Gemm g{ABUF, WIN + (size_t)NREC * D, MR, NGATE, D}; pg8::StaticOrder S; S.init(MR, NGATE, G, bx); EpiGates E{GATES, PARTB}; pg8::gemm_phase(lds, g, S, E); SEAM(7); }
    if (IN(8)) { pg8::Gemm g{Z, WGLU, MR, 2 * D, S5W}; pg8::StaticOrder S; S.init(MR, 2 * D, G, bx); EpiGlu E{GATES, YS}; pg8::gemm_phase(lds, g, S, E); SEAM(8); }
    if (IN(9)) { pg8::Gemm g{GS, WHG, MR, D, HK}; pg8::StaticOrder S; S.init(MR, D, G, bx); EpiMerge E{GATES, YS, MERGED}; pg8::gemm_phase(lds, g, S, E); SEAM(9); }
    if (IN(10)) { pg8::Gemm g{MERGED, WOUT, MR, D, D}; pg8::StaticOrder S; S.init(MR, D, G, bx); EpiRes E{HRES, x, meta, HRES, ABUF, PARTA, 1.0f, 1}; pg8::gemm_phase(lds, g, S, E); SEAM(10); }
    if (IN(11)) { pg8::Gemm g{ABUF, WGU, MR, 2 * FF, D}; pg8::StaticOrder S; S.init(MR, 2 * FF, G, bx); EpiSwiglu E{Hh, PARTA}; pg8::gemm_phase(lds, g, S, E); SEAM(11); }
    if (IN(12)) { pg8::Gemm g{Hh, WD, MR, D, FF}; pg8::StaticOrder S; S.init(MR, D, G, bx); EpiRes E{HRES, x, meta, a.out, nullptr, PARTB, 0.5f, 1}; pg8::gemm_phase(lds, g, S, E); SEAM(12); }
    if (IN(13)) {
        const float* gf = a.in[26];
        for (int row = gw; row < MR; row += NGW) {
            const float pv = lane < 32 ? PARTB[(size_t)row * 32 + lane] : 0.f; const float rstd = rsqrtf(wave_sum(pv) * (1.0f / D) + EPS);
            float* o = a.out + (size_t)row * D;
#pragma unroll
            for (int j = 0; j < 8; ++j) { f32x4 v = *(f32x4*)(o + 4 * lane + 256 * j); const f32x4 gg = *(const f32x4*)(gf + 4 * lane + 256 * j);
                v.x *= rstd * gg.x; v.y *= rstd * gg.y; v.z *= rstd * gg.z; v.w *= rstd * gg.w; *(f32x4*)(o + 4 * lane + 256 * j) = v; }
        }
    }
#undef IN
#undef SEAM
}


#ifdef DBG_STOP
struct DbgReg { const unsigned* p; size_t nwords; };
struct DbgArgs { DbgReg r[24]; int n; int pad; unsigned* sums; };
__global__ void dbg_sum(DbgArgs d) {
    for (int i = 0; i < d.n; ++i) { unsigned s = 0; for (size_t w = (size_t)blockIdx.x * blockDim.x + threadIdx.x; w < d.r[i].nwords; w += (size_t)gridDim.x * blockDim.x) s += d.r[i].p[w] * 2654435761u + (unsigned)w;
        for (int o = 1; o < 64; o <<= 1) s += __shfl_xor(s, o);
        if ((threadIdx.x & 63) == 0) atomicAdd(d.sums + i, s); }
}
__global__ void dbg_fill(float* out, const unsigned* sums, int n, size_t total) {
    for (size_t w = (size_t)blockIdx.x * blockDim.x + threadIdx.x; w < total; w += (size_t)gridDim.x * blockDim.x) out[w] = w < (size_t)n ? (float)(sums[w] & 0xFFFFFu) : 0.f;
}
#endif
constexpr int NPHASES = 14;
extern "C" void kernel_launch(void* const* d_in, const int* in_sizes, int n_in, void* d_out, int out_size, void* d_ws, size_t ws_size, hipStream_t stream) {
    static int grid = 0;
    if (grid == 0) {
        if (n_in != 27 || out_size != MR * D || ws_size < WS_END + 256) { fprintf(stderr, "kernel_launch: unexpected shapes (n_in %d out %d ws %zu need %zu)\n", n_in, out_size, ws_size, (size_t)WS_END); grid = -1; return; }
        int dev = 0, cus = 0, per_cu = 0;
        (void)hipGetDevice(&dev); (void)hipDeviceGetAttribute(&cus, hipDeviceAttributeMultiprocessorCount, dev);
        if (hipOccupancyMaxActiveBlocksPerMultiprocessor(&per_cu, (const void*)fwd, 512, 0) != hipSuccess || per_cu < 1) { fprintf(stderr, "kernel_launch: occupancy query gave %d\n", per_cu); per_cu = 1; }
        (void)hipGetLastError();
        grid = cus * 1;
        fprintf(stderr, "kernel_launch: grid %d (cus %d, per_cu %d), ws %zu need %zu\n", grid, cus, per_cu, ws_size, (size_t)WS_END);
    }
    if (grid < 0) return;
    Args a{};
    for (int i = 0; i < 27; ++i) a.in[i] = (const float*)d_in[i];
    a.out = (float*)d_out; a.ws = (unsigned char*)d_ws;
#if MK_MULTI
#ifdef DBG_STOP
    for (int p = 0; p <= DBG_STOP; ++p) { a.lo = p; a.hi = p + 1; hipLaunchKernelGGL(fwd, dim3(grid), dim3(512), 0, stream, a); }
    {
        unsigned char* ws = (unsigned char*)d_ws; DbgArgs d{}; int n = 0;
        auto add = [&](size_t off, size_t bytes) { d.r[n].p = (const unsigned*)(ws + off); d.r[n].nwords = bytes / 4; ++n; };
        const int sel = DBG_SEL;
        if (sel & 1) { add(WS_WGU, (size_t)2 * FF * D * 2); add(WS_WD, (size_t)D * FF * 2); add(WS_WIN, (size_t)INCOLS * D * 2); add(WS_WHG, (size_t)D * HK * 2); add(WS_WGLU, (size_t)2 * D * S5W * 2); add(WS_WOUT, (size_t)D * D * 2); }
        if (sel & 2) { add(WS_HRES, (size_t)MP * D * 4); add(WS_ABUF, (size_t)MP * D * 2); add(WS_PARTB, (size_t)MP * 32 * 4); }
        if (sel & 4) { add(WS_Q, (size_t)MP * HK * 2); add(WS_K, (size_t)MP * HK * 2); add(WS_V, (size_t)MP * HK * 2); add(WS_S5U, (size_t)MP * S5W * 4); }
        if (sel & 8) { add(WS_LOGF, (size_t)(MR + NMETA) * HK * 4); add(WS_DEC, (size_t)128 * NH * 128 * 4); }
        if (sel & 128) { add(WS_S5E, (size_t)128 * 2048 * 8); }
        if (sel & 16) { add(WS_GS, (size_t)MR * HK * 2); add(WS_Z, (size_t)MR * S5W * 2); }
        if (sel & 64) { add(WS_LOGF, (size_t)(MR + NMETA) * HK * 4); add(WS_GS, (size_t)MP * HK * 2); }
        if (sel & 32) { d.r[n].p = (const unsigned*)d_out; d.r[n].nwords = (size_t)128 * NH * 16384 * 2 / 4; ++n; }
        d.n = n; d.sums = (unsigned*)(ws + WS_END);
        hipMemsetAsync(ws + WS_END, 0, 256, stream);
        hipLaunchKernelGGL(dbg_sum, dim3(1024), dim3(256), 0, stream, d);
        hipLaunchKernelGGL(dbg_fill, dim3(1024), dim3(256), 0, stream, (float*)d_out, (const unsigned*)(ws + WS_END), n, (size_t)MR * D);
    }
#else
#ifdef PROBE_SEQ
    { const int seq[] = PROBE_SEQ; for (int i = 0; i < (int)(sizeof(seq) / sizeof(int)); ++i) { a.lo = seq[i]; a.hi = seq[i] + 1; hipLaunchKernelGGL(fwd, dim3(grid), dim3(512), 0, stream, a); } }
#else
    for (int p = 0; p < NPHASES; ++p) { a.lo = p; a.hi = p + 1; hipLaunchKernelGGL(fwd, dim3(grid), dim3(512), 0, stream, a); }
#endif
#endif
#else
    a.lo = 0; a.hi = NPHASES;
    void* args[] = {&a};
    hipError_t e = hipLaunchCooperativeKernel((const void*)fwd, dim3(grid), dim3(512), args, 0, stream);
    if (e != hipSuccess) fprintf(stderr, "kernel_launch: cooperative launch failed: %s (grid %d)\n", hipGetErrorString(e), grid);
#endif
}
```

```cpp
#include <hip/hip_runtime.h>
#include <hip/hip_cooperative_groups.h>
#include <cstdio>
namespace cg = cooperative_groups;

#ifndef MK_MULTI
#define MK_MULTI 0
#endif

namespace pg8 {
#define PG8_LAS __attribute__((address_space(3)))
typedef unsigned short bf16_t;
typedef short bf16x8 __attribute__((ext_vector_type(8)));
typedef float f32x4 __attribute__((ext_vector_type(4)));
typedef unsigned u32x4 __attribute__((ext_vector_type(4)));
typedef unsigned u32x2 __attribute__((ext_vector_type(2)));
constexpr int BM = 256, BK = 64, HALF = 128, HTB = HALF * BK * 2  , STAGE_BYTES = 8 * HTB, NXCD = 8, WGM = 8;

__host__ __device__ __forceinline__ int lds_byte(int r, int c) { const int st = (r >> 4) * 2 + (c >> 5), rr = r & 15, cc = c & 31, ob = rr * 64 + cc * 2; return st * 1024 + (ob ^ (((ob >> 9) & 1) << 5)); }
__host__ __device__ __forceinline__ void stage_rc(int b, int& R, int& C) { const int st = b / 1024, sb = b % 1024, swz = sb ^ (((sb >> 9) & 1) << 5); R = (st >> 1) * 16 + swz / 64; C = (st & 1) * 32 + (swz % 64) / 2; }
__host__ __device__ __forceinline__ int perm32(int rho) { const int n = rho >> 4, i = rho & 15; return 8 * (i >> 2) + 4 * n + (i & 3); }

struct Unit { int pm, pn; };
struct Gemm { const bf16_t* A; const bf16_t* Bt; int M, N, K; };

struct StaticOrder {
    int nM, nN, nwg, G, c;
    __host__ __device__ void init(int M, int N, int G_, int c_) { nM = M / BM; nN = N / BM; nwg = nM * nN; G = G_; c = c_; }
    __host__ __device__ bool next(int i, Unit& u) const {
        const long L = (long)i * G + c; if (L >= nwg) return false;
        int wgid = (int)L; { const int q = nwg / NXCD, r = nwg % NXCD, xcd = wgid % NXCD, off = wgid / NXCD; wgid = (xcd < r ? xcd * (q + 1) : r * (q + 1) + (xcd - r) * q) + off; }
        const int nig = WGM * nN, gid = wgid / nig, fm = gid * WGM, gsz = (nM - fm) < WGM ? (nM - fm) : WGM;
        u.pm = fm + ((wgid % nig) % gsz); u.pn = (wgid % nig) / gsz; return true;
    }
    __device__ __forceinline__ void a_ready(const Unit&) const {}
    __device__ __forceinline__ void done(const Unit&) const {}
};
typedef float f32x2v __attribute__((ext_vector_type(2)));
typedef __bf16 bf16x2v __attribute__((ext_vector_type(2)));
__device__ __forceinline__ unsigned cvt_pk_bf16(float lo, float hi) { const f32x2v v = {lo, hi}; const bf16x2v b = __builtin_convertvector(v, bf16x2v); return __builtin_bit_cast(unsigned, b); }

template <class Epi, class Sched>
__device__ __forceinline__ void gemm_phase(PG8_LAS unsigned char* lds, const Gemm g, const Sched& S, const Epi& E) {
    const int tid = threadIdx.x, wid = __builtin_amdgcn_readfirstlane(tid >> 6), lane = tid & 63, wr = wid >> 2, wc = wid & 3, fr = lane & 15, fq = lane >> 4;
    const int K = g.K, nt = K / BK;
    unsigned voffA[2], voffB[2];
#pragma unroll
    for (int i = 0; i < 2; ++i) { int R, C; stage_rc(tid * 16 + i * 8192, R, C); const int Rb = Epi::PERM ? ((R & ~31) + perm32(R & 31)) : R;
        voffA[i] = (unsigned)(R * K + C) * 2u; voffB[i] = (unsigned)(Rb * K + C) * 2u; }
    const size_t kstep = (size_t)(BK * 2);
    const size_t hstep = (size_t)HALF * K * 2;
    const size_t tstep = 2 * hstep;
    const unsigned ldsw = (unsigned)wid * 1024u;
    const int aoff = lds_byte(wr * 64 + fr, fq * 8), boff = lds_byte(wc * 32 + fr, fq * 8);
#define PG8_SA(b, h) (((b) * 2 + (h)) * HTB)
#define PG8_SB(b, h) ((4 + (b) * 2 + (h)) * HTB)
#define PG8_STAGE(bufoff, gbase, voff) do { _Pragma("unroll") for (int _i = 0; _i < 2; ++_i) \
        __builtin_amdgcn_global_load_lds((const unsigned*)((const char*)(gbase) + (voff)[_i]), (PG8_LAS unsigned*)(lds + (bufoff) + ldsw + _i * 8192), 16, 0, 0); } while (0)
#define PG8_LDA(dst, b, h) do { _Pragma("unroll") for (int m = 0; m < 4; ++m) _Pragma("unroll") for (int k = 0; k < 2; ++k) dst[m][k] = *(const PG8_LAS bf16x8*)(lds + PG8_SA(b, h) + aoff + m * 2048 + k * 1024); } while (0)
#define PG8_LDB(dst, b, h) do { _Pragma("unroll") for (int n = 0; n < 2; ++n) _Pragma("unroll") for (int k = 0; k < 2; ++k) dst[n][k] = *(const PG8_LAS bf16x8*)(lds + PG8_SB(b, h) + boff + n * 2048 + k * 1024); } while (0)
#define PG8_MMA(ai, bj, At, Bt) do { __builtin_amdgcn_s_setprio(1); _Pragma("unroll") for (int m = 0; m < 4; ++m) _Pragma("unroll") for (int n = 0; n < 2; ++n) _Pragma("unroll") for (int k = 0; k < 2; ++k) \
        acc[ai][bj][m][n] = __builtin_amdgcn_mfma_f32_16x16x32_bf16(Bt[n][k], At[m][k], acc[ai][bj][m][n], 0, 0, 0); __builtin_amdgcn_s_setprio(0); } while (0)
#define PG8_WAIT_V(n) asm volatile("s_waitcnt vmcnt(" #n ")" ::: "memory")
#define PG8_WAIT_L(n) asm volatile("s_waitcnt lgkmcnt(" #n ")" ::: "memory")
#define PG8_BAR __builtin_amdgcn_s_barrier()
#define PG8_SCHED __builtin_amdgcn_sched_barrier(0)
    Unit cur, nxt; int ui = 0;
    if (!S.next(0, cur)) return;
    f32x4 acc[2][2][4][2];
#pragma unroll
    for (int a = 0; a < 2; ++a)
#pragma unroll
        for (int b = 0; b < 2; ++b)
#pragma unroll
            for (int m = 0; m < 4; ++m)
#pragma unroll
                for (int n = 0; n < 2; ++n) acc[a][b][m][n] = (f32x4){0.f, 0.f, 0.f, 0.f};
    bf16x8 At[4][2], B0[2][2], B1[2][2];
    const char* cA = (const char*)g.A + (size_t)cur.pm * tstep; const char* cB = (const char*)g.Bt + (size_t)cur.pn * tstep;
    S.a_ready(cur);
    PG8_STAGE(PG8_SB(0, 0), cB, voffB); PG8_STAGE(PG8_SA(0, 0), cA, voffA); PG8_STAGE(PG8_SB(0, 1), cB + hstep, voffB); PG8_STAGE(PG8_SA(0, 1), cA + hstep, voffA);
    if (wr == 1) PG8_BAR;
    PG8_WAIT_V(4); PG8_BAR;
    PG8_STAGE(PG8_SB(1, 0), cB + kstep, voffB); PG8_STAGE(PG8_SA(1, 0), cA + kstep, voffA); PG8_STAGE(PG8_SB(1, 1), cB + hstep + kstep, voffB);
    PG8_WAIT_V(6); PG8_BAR;
    for (;;) {
        const bool has_next = S.next(ui + 1, nxt);
        const char* nA = has_next ? (const char*)g.A + (size_t)nxt.pm * tstep : cA; const char* nB = has_next ? (const char*)g.Bt + (size_t)nxt.pn * tstep : cB;
        for (int t = 0; t < nt; t += 2) {
            const bool last = (t == nt - 2);
            const char* a1 = cA + (size_t)(t + 1) * kstep;
            const char* a2 = last ? nA : cA + (size_t)(t + 2) * kstep; const char* b2 = last ? nB : cB + (size_t)(t + 2) * kstep;
            const char* a3 = a2 + kstep; const char* b3 = b2 + kstep;
            if (last && has_next) S.a_ready(nxt);
            PG8_LDB(B0, 0, 0); PG8_SCHED; PG8_LDA(At, 0, 0); PG8_STAGE(PG8_SA(1, 1), a1 + hstep, voffA);
            PG8_WAIT_L(8); PG8_BAR; PG8_WAIT_L(0); PG8_MMA(0, 0, At, B0); PG8_BAR; PG8_SCHED;
            PG8_LDB(B1, 0, 1); PG8_STAGE(PG8_SB(0, 0), b2, voffB);
            PG8_BAR; PG8_WAIT_L(0); PG8_MMA(0, 1, At, B1); PG8_BAR;
            PG8_LDA(At, 0, 1); PG8_STAGE(PG8_SA(0, 0), a2, voffA);
            PG8_BAR; PG8_WAIT_L(0); PG8_MMA(1, 0, At, B0); PG8_BAR; PG8_SCHED;
            PG8_STAGE(PG8_SB(0, 1), b2 + hstep, voffB);
            PG8_WAIT_V(6); PG8_BAR; PG8_MMA(1, 1, At, B1); PG8_BAR;
            PG8_LDB(B0, 1, 0); PG8_SCHED; PG8_LDA(At, 1, 0); PG8_STAGE(PG8_SA(0, 1), a2 + hstep, voffA);
            PG8_WAIT_L(8); PG8_BAR; PG8_WAIT_L(0); PG8_MMA(0, 0, At, B0); PG8_BAR; PG8_SCHED;
            PG8_LDB(B1, 1, 1); PG8_STAGE(PG8_SB(1, 0), b3, voffB);
            PG8_BAR; PG8_WAIT_L(0); PG8_MMA(0, 1, At, B1); PG8_BAR;
            PG8_LDA(At, 1, 1); PG8_STAGE(PG8_SA(1, 0), a3, voffA);
            PG8_BAR; PG8_WAIT_L(0); PG8_MMA(1, 0, At, B0); PG8_BAR; PG8_SCHED;
            PG8_STAGE(PG8_SB(1, 1), b3 + hstep, voffB);
            PG8_WAIT_V(6); PG8_BAR; PG8_MMA(1, 1, At, B1); PG8_BAR;
        }
        if constexpr (!Epi::AFTER_DRAIN) { E(acc, cur, wr, wc, fr, fq); S.done(cur); }
        if (!has_next) break;
#pragma unroll
        for (int a = 0; a < 2; ++a)
#pragma unroll
            for (int b = 0; b < 2; ++b)
#pragma unroll
                for (int m = 0; m < 4; ++m)
#pragma unroll
                    for (int n = 0; n < 2; ++n) acc[a][b][m][n] = (f32x4){0.f, 0.f, 0.f, 0.f};
        cur = nxt; cA = nA; cB = nB; ++ui;
    }
    PG8_WAIT_V(0);
    if (wr == 0) PG8_BAR;
    PG8_BAR;
    if constexpr (Epi::AFTER_DRAIN) { E.fused(acc, cur, wr, wc, fr, fq, lds, wid, lane); S.done(cur); }
#undef PG8_SA
#undef PG8_SB
#undef PG8_STAGE
#undef PG8_LDA
#undef PG8_LDB
#undef PG8_MMA
#undef PG8_WAIT_V
#undef PG8_WAIT_L
#undef PG8_BAR
#undef PG8_SCHED
}
}

using pg8::bf16_t; using pg8::bf16x8; using pg8::f32x4; using pg8::u32x4; using pg8::u32x2; using pg8::cvt_pk_bf16;
#define LAS __attribute__((address_space(3)))
constexpr int D = 2048, FF = 5632, MR = 8192, NMETA = 16, MP = 8448;
constexpr int HK = 1536, NH = 12, S5W = 512, NS = 64;
constexpr int NREC = 6656, NGATE = 4096, INCOLS = 10752, NCH = 129;
constexpr float EPS = 1e-6f;
constexpr int LDS_BYTES = 131072;

constexpr size_t WS_WGU  = 0;
constexpr size_t WS_WD   = WS_WGU  + (size_t)2 * FF * D * 2;
constexpr size_t WS_WIN  = WS_WD   + (size_t)D * FF * 2;
constexpr size_t WS_WHG  = WS_WIN  + (size_t)INCOLS * D * 2;
constexpr size_t WS_WGLU = WS_WHG  + (size_t)D * HK * 2;
constexpr size_t WS_WOUT = WS_WGLU + (size_t)2 * D * S5W * 2;
constexpr size_t WS_HRES = WS_WOUT + (size_t)D * D * 2;
constexpr size_t WS_ABUF = WS_HRES + (size_t)MP * D * 4;
constexpr size_t WS_Q    = WS_ABUF + (size_t)MP * D * 2;
constexpr size_t WS_K    = WS_Q    + (size_t)MP * HK * 2;
constexpr size_t WS_LOGF = WS_K    + (size_t)MP * HK * 2;
constexpr size_t WS_V    = WS_LOGF + (size_t)MP * HK * 4;
constexpr size_t WS_GS   = WS_V    + (size_t)MP * HK * 2;
constexpr size_t WS_S5U  = WS_GS   + (size_t)MP * HK * 2;
constexpr size_t WS_Z    = WS_S5U  + (size_t)MP * S5W * 4;
constexpr size_t WS_PARTA= WS_Z    + (size_t)MR * S5W * 2;
constexpr size_t WS_PARTB= WS_PARTA+ (size_t)MP * 32 * 4;
constexpr size_t WS_DEC  = WS_PARTB+ (size_t)MP * 32 * 4;
constexpr size_t WS_S5E  = WS_DEC  + (size_t)128 * NH * 128 * 4;
constexpr size_t WS_END  = WS_S5E  + (size_t)NCH * 2048 * 8;
constexpr size_t WS_H     = WS_Q;
constexpr size_t WS_GATES = WS_Q;
static_assert((size_t)MP * FF * 2 <= WS_V - WS_Q, "H alias");
constexpr size_t DO_YS = 0, DO_MERGED = (size_t)MR * D * 2;

struct Args { const float* in[27]; float* out; unsigned char* ws; int lo, hi; };

__device__ __forceinline__ float bf_lo(unsigned w) { return __uint_as_float(w << 16); }
__device__ __forceinline__ float bf_hi(unsigned w) { return __uint_as_float(w & 0xffff0000u); }
__device__ __forceinline__ float bf2f(bf16_t b) { return __uint_as_float(((unsigned)b) << 16); }
__device__ __forceinline__ float fsigmoid(float x) { return __builtin_amdgcn_rcpf(1.0f + __expf(-x)); }
__device__ __forceinline__ float fsilu(float x) { return x * fsigmoid(x); }
#define LDS_WAIT() asm volatile("s_waitcnt lgkmcnt(0)" ::: "memory")

__device__ __forceinline__ void row_rstd(const float* part, int row0, int fq, float (&rs)[2][4]) {
#pragma unroll
    for (int ai = 0; ai < 2; ++ai)
#pragma unroll
        for (int m = 0; m < 4; ++m) {
            const f32x4* p = (const f32x4*)(part + (size_t)(row0 + ai * 128 + m * 16) * 32 + fq * 8);
            const f32x4 a = p[0], b = p[1];
            float s = ((a.x + a.y) + (a.z + a.w)) + ((b.x + b.y) + (b.z + b.w));
            s += __shfl_xor(s, 16); s += __shfl_xor(s, 32);
            rs[ai][m] = rsqrtf(s * (1.0f / D) + EPS);
        }
}
struct EpiSwiglu {
    static constexpr bool PERM = true, AFTER_DRAIN = false;
    bf16_t* H; const float* part;
    __device__ __forceinline__ void operator()(const f32x4 (&acc)[2][2][4][2], const pg8::Unit& u, int wr, int wc, int fr, int fq) const {
        const int row0 = u.pm * 256 + wr * 64 + fr, col0 = u.pn * 128 + wc * 32 + 8 * fq;
        float rs[2][4]; row_rstd(part, row0, fq, rs);
#pragma unroll
        for (int ai = 0; ai < 2; ++ai)
#pragma unroll
            for (int m = 0; m < 4; ++m) {
                const float r = rs[ai][m]; float h[8];
#pragma unroll
                for (int n = 0; n < 2; ++n)
#pragma unroll
                    for (int j = 0; j < 4; ++j) h[n * 4 + j] = fsilu(acc[ai][0][m][n][j] * r) * (acc[ai][1][m][n][j] * r);
                u32x4 w; w.x = cvt_pk_bf16(h[0], h[1]); w.y = cvt_pk_bf16(h[2], h[3]); w.z = cvt_pk_bf16(h[4], h[5]); w.w = cvt_pk_bf16(h[6], h[7]);
                *(u32x4*)(H + (size_t)(row0 + ai * 128 + m * 16) * FF + col0) = w;
            }
    }
};
struct EpiRes {
    static constexpr bool PERM = false, AFTER_DRAIN = false;
    const float* res; const float* x; const float* meta; float* out; bf16_t* outb; float* part; float alpha; int mode;
    __device__ __forceinline__ void operator()(const f32x4 (&acc)[2][2][4][2], const pg8::Unit& u, int wr, int wc, int fr, int fq) const {
        const int row0 = u.pm * 256 + wr * 64 + fr, col0 = u.pn * 256 + wc * 32 + 4 * fq;
#pragma unroll
        for (int ai = 0; ai < 2; ++ai)
#pragma unroll
            for (int m = 0; m < 4; ++m) {
                const int row = row0 + ai * 128 + m * 16;
                const float* rp = mode ? res + (size_t)row * D : (row < MR ? x + (size_t)row * D : (row < MR + NMETA ? meta + (size_t)(row - MR) * D : nullptr));
                float ss = 0.f;
#pragma unroll
                for (int bj = 0; bj < 2; ++bj)
#pragma unroll
                    for (int n = 0; n < 2; ++n) {
                        const int c = col0 + bj * 128 + n * 16;
                        f32x4 r = rp ? *(const f32x4*)(rp + c) : (f32x4){0.f, 0.f, 0.f, 0.f};
                        const f32x4 o = r + acc[ai][bj][m][n] * alpha;
                        *(f32x4*)(out + (size_t)row * D + c) = o;
                        ss += (o.x * o.x + o.y * o.y) + (o.z * o.z + o.w * o.w);
                        if (outb) { u32x2 w; w.x = cvt_pk_bf16(o.x, o.y); w.y = cvt_pk_bf16(o.z, o.w); *(u32x2*)(outb + (size_t)row * D + c) = w; }
                    }
                ss += __shfl_xor(ss, 16); ss += __shfl_xor(ss, 32);
                if (fq == 0) part[(size_t)row * 32 + u.pn * 4 + wc] = ss;
            }
    }
};
struct EpiRec {
    static constexpr bool PERM = true, AFTER_DRAIN = false;
    bf16_t *Q, *Kb, *V, *GS; float *LOGF, *S5U; const float* part; const float* lbp;
    __device__ __forceinline__ void operator()(const f32x4 (&acc)[2][2][4][2], const pg8::Unit& u, int wr, int wc, int fr, int fq) const {
        const int row0 = u.pm * 256 + wr * 64 + fr, colt = u.pn * 256 + wc * 32 + 8 * fq;
        float rs[2][4]; row_rstd(part, row0, fq, rs);
        const int seg = u.pn < 6 ? 0 : (u.pn < 12 ? 1 : (u.pn < 18 ? 2 : (u.pn < 24 ? 3 : 4)));
#pragma unroll
        for (int bj = 0; bj < 2; ++bj) {
            const int c = colt + bj * 128;
            float lb[8];
            if (seg == 1) {
#pragma unroll
                for (int e = 0; e < 8; ++e) { const float a0 = lbp[c - HK + e], a1 = lbp[HK + c - HK + e]; lb[e] = 1.0f / (1.0f + expf(a1 - a0)); }
            }
#pragma unroll
            for (int ai = 0; ai < 2; ++ai)
#pragma unroll
                for (int m = 0; m < 4; ++m) {
                    const size_t row = (size_t)(row0 + ai * 128 + m * 16); const float r = rs[ai][m];
                    float v[8];
#pragma unroll
                    for (int n = 0; n < 2; ++n)
#pragma unroll
                        for (int j = 0; j < 4; ++j) v[n * 4 + j] = acc[ai][bj][m][n][j] * r;
                    if (seg == 0) {
#pragma unroll
                        for (int e = 0; e < 8; ++e) v[e] = fsilu(v[e]) * 0.08838834764831845f;
                        u32x4 w; w.x = cvt_pk_bf16(v[0], v[1]); w.y = cvt_pk_bf16(v[2], v[3]); w.z = cvt_pk_bf16(v[4], v[5]); w.w = cvt_pk_bf16(v[6], v[7]);
                        *(u32x4*)(Q + row * HK + c) = w;
                    } else if (seg == 1) {
                        float kk[8], lf[8];
#pragma unroll
                        for (int e = 0; e < 8; ++e) { const float sg = 1.0f / (1.0f + __expf(-v[e])); const float f = lb[e] + (1.0f - lb[e]) * sg; kk[e] = 1.0f - f; lf[e] = __logf(f); }
                        u32x4 w; w.x = cvt_pk_bf16(kk[0], kk[1]); w.y = cvt_pk_bf16(kk[2], kk[3]); w.z = cvt_pk_bf16(kk[4], kk[5]); w.w = cvt_pk_bf16(kk[6], kk[7]);
                        *(u32x4*)(Kb + row * HK + (c - HK)) = w;
                        *(f32x4*)(LOGF + row * HK + (c - HK)) = (f32x4){lf[0], lf[1], lf[2], lf[3]};
                        *(f32x4*)(LOGF + row * HK + (c - HK) + 4) = (f32x4){lf[4], lf[5], lf[6], lf[7]};
                    } else if (seg == 2) {
                        u32x4 w; w.x = cvt_pk_bf16(v[0], v[1]); w.y = cvt_pk_bf16(v[2], v[3]); w.z = cvt_pk_bf16(v[4], v[5]); w.w = cvt_pk_bf16(v[6], v[7]);
                        *(u32x4*)(V + row * HK + (c - 2 * HK)) = w;
                    } else if (seg == 3) {
#pragma unroll
                        for (int e = 0; e < 8; ++e) v[e] = fsilu(v[e]);
                        u32x4 w; w.x = cvt_pk_bf16(v[0], v[1]); w.y = cvt_pk_bf16(v[2], v[3]); w.z = cvt_pk_bf16(v[4], v[5]); w.w = cvt_pk_bf16(v[6], v[7]);
                        *(u32x4*)(GS + row * HK + (c - 3 * HK)) = w;
                    } else {
                        *(f32x4*)(S5U + row * S5W + (c - 4 * HK)) = (f32x4){v[0], v[1], v[2], v[3]};
                        *(f32x4*)(S5U + row * S5W + (c - 4 * HK) + 4) = (f32x4){v[4], v[5], v[6], v[7]};
                    }
                }
        }
    }
};
struct EpiGates {
    static constexpr bool PERM = true, AFTER_DRAIN = false;
    bf16_t* G; const float* part;
    __device__ __forceinline__ void operator()(const f32x4 (&acc)[2][2][4][2], const pg8::Unit& u, int wr, int wc, int fr, int fq) const {
        const int row0 = u.pm * 256 + wr * 64 + fr, colt = u.pn * 256 + wc * 32 + 8 * fq;
        float rs[2][4]; row_rstd(part, row0, fq, rs);
#pragma unroll
        for (int ai = 0; ai < 2; ++ai)
#pragma unroll
            for (int m = 0; m < 4; ++m) {
                const float r = rs[ai][m];
#pragma unroll
                for (int bj = 0; bj < 2; ++bj) {
                    float v[8];
#pragma unroll
                    for (int n = 0; n < 2; ++n)
#pragma unroll
                        for (int j = 0; j < 4; ++j) v[n * 4 + j] = fsigmoid(acc[ai][bj][m][n][j] * r);
                    u32x4 w; w.x = cvt_pk_bf16(v[0], v[1]); w.y = cvt_pk_bf16(v[2], v[3]); w.z = cvt_pk_bf16(v[4], v[5]); w.w = cvt_pk_bf16(v[6], v[7]);
                    *(u32x4*)(G + (size_t)(row0 + ai * 128 + m * 16) * NGATE + colt + bj * 128) = w;
                }
            }
    }
};
struct EpiGlu {
    static constexpr bool PERM = true, AFTER_DRAIN = false;
    const bf16_t* G; bf16_t* YS;
    __device__ __forceinline__ void operator()(const f32x4 (&acc)[2][2][4][2], const pg8::Unit& u, int wr, int wc, int fr, int fq) const {
        const int row0 = u.pm * 256 + wr * 64 + fr, col0 = u.pn * 128 + wc * 32 + 8 * fq;
#pragma unroll
        for (int ai = 0; ai < 2; ++ai)
#pragma unroll
            for (int m = 0; m < 4; ++m) {
                const size_t row = (size_t)(row0 + ai * 128 + m * 16);
                float y[8];
#pragma unroll
                for (int n = 0; n < 2; ++n)
#pragma unroll
                    for (int j = 0; j < 4; ++j) y[n * 4 + j] = acc[ai][0][m][n][j] * fsigmoid(acc[ai][1][m][n][j]);
                u32x4 w; w.x = cvt_pk_bf16(y[0], y[1]); w.y = cvt_pk_bf16(y[2], y[3]); w.z = cvt_pk_bf16(y[4], y[5]); w.w = cvt_pk_bf16(y[6], y[7]);
                *(u32x4*)(YS + row * D + col0) = w;
            }
    }
};
struct EpiMerge {
    static constexpr bool PERM = true, AFTER_DRAIN = false;
    const bf16_t* G; const bf16_t* YS; bf16_t* MG;
    __device__ __forceinline__ void operator()(const f32x4 (&acc)[2][2][4][2], const pg8::Unit& u, int wr, int wc, int fr, int fq) const {
        const int row0 = u.pm * 256 + wr * 64 + fr, colt = u.pn * 256 + wc * 32 + 8 * fq;
#pragma unroll
        for (int ai = 0; ai < 2; ++ai)
#pragma unroll
            for (int m = 0; m < 4; ++m) {
                const size_t row = (size_t)(row0 + ai * 128 + m * 16);
#pragma unroll
                for (int bj = 0; bj < 2; ++bj) {
                    const int c = colt + bj * 128;
                    const u32x4 gw = *(const u32x4*)(G + row * NGATE + c), sw = *(const u32x4*)(G + row * NGATE + D + c), yw = *(const u32x4*)(YS + row * D + c);
                    const float g[8] = {bf_lo(gw.x), bf_hi(gw.x), bf_lo(gw.y), bf_hi(gw.y), bf_lo(gw.z), bf_hi(gw.z), bf_lo(gw.w), bf_hi(gw.w)};
                    const float gs5[8] = {bf_lo(sw.x), bf_hi(sw.x), bf_lo(sw.y), bf_hi(sw.y), bf_lo(sw.z), bf_hi(sw.z), bf_lo(sw.w), bf_hi(sw.w)};
                    const float y[8] = {bf_lo(yw.x), bf_hi(yw.x), bf_lo(yw.y), bf_hi(yw.y), bf_lo(yw.z), bf_hi(yw.z), bf_lo(yw.w), bf_hi(yw.w)};
                    float o[8];
#pragma unroll
                    for (int n = 0; n < 2; ++n)
#pragma unroll
                        for (int j = 0; j < 4; ++j) o[n * 4 + j] = g[n * 4 + j] * acc[ai][bj][m][n][j] + gs5[n * 4 + j] * y[n * 4 + j];
                    u32x4 w; w.x = cvt_pk_bf16(o[0], o[1]); w.y = cvt_pk_bf16(o[2], o[3]); w.z = cvt_pk_bf16(o[4], o[5]); w.w = cvt_pk_bf16(o[6], o[7]);
                    *(u32x4*)(MG + row * D + c) = w;
                }
            }
    }
};

__device__ __forceinline__ float wave_sum(float v) {
#pragma unroll
    for (int o = 1; o < 64; o <<= 1) v += __shfl_xor(v, o);
    return v;
}
__device__ __forceinline__ void tr_item(const float* W, int K, int N, bf16_t* WT, const float* gain, int ilv, LAS float* scr, int item, int lane) {
    const int nblk = N / 32, kb = item / nblk, nb = item - kb * nblk, k0 = 64 * kb, n0 = 32 * nb;
    float wv[32];
    const float* wp = W + (size_t)(k0 + (lane >> 5)) * N + n0 + (lane & 31);
#pragma unroll
    for (int i = 0; i < 32; ++i) wv[i] = __builtin_nontemporal_load(wp + (size_t)(2 * i) * N);
    const float gl = gain ? gain[k0 + lane] : 1.0f;
#pragma unroll
    for (int i = 0; i < 32; ++i) { const float g0 = __int_as_float(__builtin_amdgcn_readlane(__float_as_int(gl), 2 * i)), g1 = __int_as_float(__builtin_amdgcn_readlane(__float_as_int(gl), 2 * i + 1)); scr[(2 * i + (lane >> 5)) * 33 + (lane & 31)] = wv[i] * ((lane >> 5) ? g1 : g0); }
    LDS_WAIT();
    const int c = lane & 7;
#pragma unroll
    for (int j = 0; j < 4; ++j) { const int n = (lane >> 3) + 8 * j; const LAS float* s = scr + (8 * c) * 33 + n;
        u32x4 o; o.x = cvt_pk_bf16(s[0 * 33], s[1 * 33]); o.y = cvt_pk_bf16(s[2 * 33], s[3 * 33]); o.z = cvt_pk_bf16(s[4 * 33], s[5 * 33]); o.w = cvt_pk_bf16(s[6 * 33], s[7 * 33]);
        const int nn = n0 + n; const int drow = ilv ? ((nn >> 7) * 256 + (ilv - 1) * 128 + (nn & 127)) : nn;
        *(u32x4*)(WT + (size_t)drow * K + k0 + 8 * c) = o; }
    LDS_WAIT();
}
struct TrJob { const float* W; int K, N; bf16_t* WT; const float* gain; int ilv; };
__device__ __forceinline__ void tr_run(const TrJob& j, int& it, int NGW, LAS float* scr, int lane) {
    const int n = (j.K / 64) * (j.N / 32);
    for (; it < n; it += NGW) tr_item(j.W, j.K, j.N, j.WT, j.gain, j.ilv, scr, it, lane);
    it -= n;
}

__device__ __forceinline__ void skinny_down(LAS unsigned char* lds, int tile, const bf16_t* Hm, const bf16_t* Wd, const float* meta, bf16_t* ABUF, float* PARTB, int wave, int lane) {
    const int lr = lane & 15, lq = lane >> 4, n0 = 16 * tile, kbase = wave * (FF / 8);
    const bf16_t* ap = Hm + (size_t)lr * FF + kbase + 8 * lq; const bf16_t* bp = Wd + (size_t)(n0 + lr) * FF + kbase + 8 * lq;
    f32x4 acc = (f32x4){0.f, 0.f, 0.f, 0.f};
#pragma unroll 11
    for (int s = 0; s < FF / 8 / 32; ++s) { const bf16x8 af = *(const bf16x8*)(ap + 32 * s), bf = *(const bf16x8*)(bp + 32 * s); acc = __builtin_amdgcn_mfma_f32_16x16x32_bf16(bf, af, acc, 0, 0, 0); }
    *(LAS f32x4*)(lds + (wave * 64 + lane) * 16) = acc;
    __syncthreads();
    if (wave == 0) {
        f32x4 t = (f32x4){0.f, 0.f, 0.f, 0.f};
#pragma unroll
        for (int w = 0; w < 8; ++w) t += *(const LAS f32x4*)(lds + (w * 64 + lane) * 16);
        const int col = n0 + 4 * lq; const f32x4 r = *(const f32x4*)(meta + (size_t)lr * D + col); const f32x4 o = r + t * 0.5f;
        u32x2 w2; w2.x = cvt_pk_bf16(o.x, o.y); w2.y = cvt_pk_bf16(o.z, o.w); *(u32x2*)(ABUF + (size_t)(MR + lr) * D + col) = w2;
        float ss = (o.x * o.x + o.y * o.y) + (o.z * o.z + o.w * o.w); ss += __shfl_xor(ss, 16); ss += __shfl_xor(ss, 32);
        if (lq == 0) atomicAdd(PARTB + (size_t)(MR + lr) * 32 + (tile & 31), ss);
    }
    __syncthreads();
}

constexpr int HG_A1 = 0, HG_A2 = 17408, HG_BK = 34816, HG_ST = 52224, HG_VT = 87040, HG_P = 105472, HG_SSQ = 114688;
constexpr int HL_KT = 0, HL_VT = 18432, HL_QT = 36864;
__device__ __forceinline__ void hg_local_item(LAS unsigned char* lds, int item, float* LOGF, const bf16_t* Kb, const bf16_t* Vb, bf16_t* ST, float* DEC, int tid, int wave, int lane) {
    const int c = item / NH, h = item - c * NH;
    const int row0 = c == 0 ? MR : 64 * (c - 1), T = c == 0 ? NMETA : 64;
    const int kcol = tid & 127, tq = tid >> 7;
    float* LF = LOGF + (size_t)row0 * HK + h * 128 + kcol;
    LAS float* qt = (LAS float*)(lds + HL_QT);
    float cs[16]; float run = 0.f; unsigned kraw[16], vv[16];
    {
        const bf16_t* KP = Kb + (size_t)row0 * HK + h * 128 + kcol; const bf16_t* VP = Vb + (size_t)row0 * HK + h * 128 + kcol;
#pragma unroll
        for (int i = 0; i < 16; ++i) { const int t = tq * 16 + i; const bool ok = t < T; cs[i] = ok ? LF[(size_t)t * HK] : 0.f; kraw[i] = ok ? (unsigned)KP[(size_t)t * HK] : 0u; vv[i] = ok ? (unsigned)VP[(size_t)t * HK] : 0u; }
    }
#pragma unroll
    for (int i = 0; i < 16; ++i) { run += cs[i]; cs[i] = run; }
    qt[tq * 128 + kcol] = run;
    __syncthreads();
    float pre = 0.f, tot = 0.f;
#pragma unroll
    for (int q = 0; q < 4; ++q) { const float x = qt[q * 128 + kcol]; tot += x; if (q < tq) pre += x; }
#pragma unroll
    for (int i = 0; i < 16; ++i) { const int t = tq * 16 + i; cs[i] += pre; if (t < T) LF[(size_t)t * HK] = cs[i]; }
    if (c == NCH - 1) { __syncthreads(); return; }
    {
        float kd[16];
#pragma unroll
        for (int i = 0; i < 16; ++i) kd[i] = __uint_as_float(kraw[i] << 16) * __expf(tot - cs[i]);
        u32x4 a, b;
        a.x = cvt_pk_bf16(kd[0], kd[1]); a.y = cvt_pk_bf16(kd[2], kd[3]); a.z = cvt_pk_bf16(kd[4], kd[5]); a.w = cvt_pk_bf16(kd[6], kd[7]);
        b.x = cvt_pk_bf16(kd[8], kd[9]); b.y = cvt_pk_bf16(kd[10], kd[11]); b.z = cvt_pk_bf16(kd[12], kd[13]); b.w = cvt_pk_bf16(kd[14], kd[15]);
        *(LAS u32x4*)(lds + HL_KT + kcol * 144 + tq * 32) = a; *(LAS u32x4*)(lds + HL_KT + kcol * 144 + tq * 32 + 16) = b;
        a.x = vv[0] | (vv[1] << 16); a.y = vv[2] | (vv[3] << 16); a.z = vv[4] | (vv[5] << 16); a.w = vv[6] | (vv[7] << 16);
        b.x = vv[8] | (vv[9] << 16); b.y = vv[10] | (vv[11] << 16); b.z = vv[12] | (vv[13] << 16); b.w = vv[14] | (vv[15] << 16);
        *(LAS u32x4*)(lds + HL_VT + kcol * 144 + tq * 32) = a; *(LAS u32x4*)(lds + HL_VT + kcol * 144 + tq * 32 + 16) = b;
        if (tq == 0) DEC[(size_t)(c * NH + h) * 128 + kcol] = __expf(tot);
    }
    __syncthreads();
    {
        const int vt0 = (wave >> 1) * 2, kt0 = (wave & 1) * 4, lr = lane & 15, lq = lane >> 4;
        f32x4 acc[2][4];
#pragma unroll
        for (int a = 0; a < 2; ++a)
#pragma unroll
            for (int b = 0; b < 4; ++b) acc[a][b] = (f32x4){0.f, 0.f, 0.f, 0.f};
#pragma unroll
        for (int ks = 0; ks < 2; ++ks) {
            bf16x8 vf[2], kf[4];
#pragma unroll
            for (int a = 0; a < 2; ++a) vf[a] = *(const LAS bf16x8*)(lds + HL_VT + (16 * (vt0 + a) + lr) * 144 + (ks * 32 + 8 * lq) * 2);
#pragma unroll
            for (int b = 0; b < 4; ++b) kf[b] = *(const LAS bf16x8*)(lds + HL_KT + (16 * (kt0 + b) + lr) * 144 + (ks * 32 + 8 * lq) * 2);
#pragma unroll
            for (int a = 0; a < 2; ++a)
#pragma unroll
                for (int b = 0; b < 4; ++b) acc[a][b] = __builtin_amdgcn_mfma_f32_16x16x32_bf16(kf[b], vf[a], acc[a][b], 0, 0, 0);
        }
        bf16_t* dst = ST + (size_t)(c * NH + h) * 16384;
#pragma unroll
        for (int a = 0; a < 2; ++a)
#pragma unroll
            for (int b = 0; b < 4; ++b) { const int v = 16 * (vt0 + a) + lr, k = 16 * (kt0 + b) + 4 * lq;
                u32x2 w; w.x = cvt_pk_bf16(acc[a][b].x, acc[a][b].y); w.y = cvt_pk_bf16(acc[a][b].z, acc[a][b].w);
                *(u32x2*)(dst + v * 128 + k) = w; }
    }
    __syncthreads();
}
__device__ __forceinline__ void hg_out_item(LAS unsigned char* lds, int item, const float* B, const bf16_t* Q, const bf16_t* Kb, const bf16_t* Vb, const bf16_t* ST, bf16_t* GS, const float* hg_norm, int tid, int wave, int lane) {
    const int c = 1 + item / NH, h = item % NH, row0 = 64 * (c - 1);
    u32x2 gpre[4];
#pragma unroll
    for (int tt = 0; tt < 4; ++tt) gpre[tt] = *(const u32x2*)(GS + (size_t)(row0 + 16 * tt + (lane & 15)) * HK + h * 128 + 16 * wave + 4 * (lane >> 4));
#pragma unroll
    for (int jj = 0; jj < 2; ++jj) {
        const int p = tid + 512 * jj, t = p >> 4, k0 = 8 * (p & 15);
        const size_t off = (size_t)(row0 + t) * HK + h * 128 + k0, roff = (size_t)(row0 + 31) * HK + h * 128 + k0;
        const f32x4 b0 = *(const f32x4*)(B + off), b1 = *(const f32x4*)(B + off + 4), r0 = *(const f32x4*)(B + roff), r1 = *(const f32x4*)(B + roff + 4);
        const u32x4 qw = *(const u32x4*)(Q + off), kw = *(const u32x4*)(Kb + off);
        const float bb[8] = {b0.x, b0.y, b0.z, b0.w, b1.x, b1.y, b1.z, b1.w}, rr[8] = {r0.x, r0.y, r0.z, r0.w, r1.x, r1.y, r1.z, r1.w};
        const float qq[8] = {bf_lo(qw.x), bf_hi(qw.x), bf_lo(qw.y), bf_hi(qw.y), bf_lo(qw.z), bf_hi(qw.z), bf_lo(qw.w), bf_hi(qw.w)};
        const float kk[8] = {bf_lo(kw.x), bf_hi(kw.x), bf_lo(kw.y), bf_hi(kw.y), bf_lo(kw.z), bf_hi(kw.z), bf_lo(kw.w), bf_hi(kw.w)};
        float a1[8], a2[8], bk[8];
#pragma unroll
        for (int e = 0; e < 8; ++e) { a1[e] = qq[e] * __expf(bb[e]); a2[e] = qq[e] * __expf(bb[e] - rr[e]); bk[e] = kk[e] * __expf(rr[e] - bb[e]); }
        u32x4 w;
        w.x = cvt_pk_bf16(a1[0], a1[1]); w.y = cvt_pk_bf16(a1[2], a1[3]); w.z = cvt_pk_bf16(a1[4], a1[5]); w.w = cvt_pk_bf16(a1[6], a1[7]); *(LAS u32x4*)(lds + HG_A1 + t * 272 + k0 * 2) = w;
        w.x = cvt_pk_bf16(a2[0], a2[1]); w.y = cvt_pk_bf16(a2[2], a2[3]); w.z = cvt_pk_bf16(a2[4], a2[5]); w.w = cvt_pk_bf16(a2[6], a2[7]); *(LAS u32x4*)(lds + HG_A2 + t * 272 + k0 * 2) = w;
        w.x = cvt_pk_bf16(bk[0], bk[1]); w.y = cvt_pk_bf16(bk[2], bk[3]); w.z = cvt_pk_bf16(bk[4], bk[5]); w.w = cvt_pk_bf16(bk[6], bk[7]); *(LAS u32x4*)(lds + HG_BK + t * 272 + k0 * 2) = w;
    }
    {
        const int vcol = tid & 127, tq = tid >> 7; const bf16_t* VP = Vb + (size_t)(row0 + tq * 16) * HK + h * 128 + vcol; unsigned vv[16];
#pragma unroll
        for (int i = 0; i < 16; ++i) vv[i] = (unsigned)VP[(size_t)i * HK];
        u32x4 a, b;
        a.x = vv[0] | (vv[1] << 16); a.y = vv[2] | (vv[3] << 16); a.z = vv[4] | (vv[5] << 16); a.w = vv[6] | (vv[7] << 16);
        b.x = vv[8] | (vv[9] << 16); b.y = vv[10] | (vv[11] << 16); b.z = vv[12] | (vv[13] << 16); b.w = vv[14] | (vv[15] << 16);
        *(LAS u32x4*)(lds + HG_VT + vcol * 144 + tq * 32) = a; *(LAS u32x4*)(lds + HG_VT + vcol * 144 + tq * 32 + 16) = b;
    }
    {
        const u32x4* src = (const u32x4*)(ST + (size_t)(c * NH + h) * 16384);
#pragma unroll
        for (int jj = 0; jj < 4; ++jj) { const int idx = tid + 512 * jj; *(LAS u32x4*)(lds + HG_ST + (idx >> 4) * 272 + (idx & 15) * 16) = src[idx]; }
    }
    __syncthreads();
    const int lr = lane & 15, lq = lane >> 4;
    {
        const int tt = wave >> 1;
#pragma unroll
        for (int sh = 0; sh < 2; ++sh) {
            const int ss = 2 * (wave & 1) + sh;
            f32x4 acc = (f32x4){0.f, 0.f, 0.f, 0.f};
            if (ss <= tt) {
#pragma unroll
                for (int ks = 0; ks < 4; ++ks) {
                    const bf16x8 af = *(const LAS bf16x8*)(lds + HG_A2 + (16 * tt + lr) * 272 + (ks * 32 + 8 * lq) * 2);
                    const bf16x8 bf = *(const LAS bf16x8*)(lds + HG_BK + (16 * ss + lr) * 272 + (ks * 32 + 8 * lq) * 2);
                    acc = __builtin_amdgcn_mfma_f32_16x16x32_bf16(bf, af, acc, 0, 0, 0);
                }
            }
            const int t = 16 * tt + lr, s0 = 16 * ss + 4 * lq;
            float pv[4];
#pragma unroll
            for (int r = 0; r < 4; ++r) pv[r] = (s0 + r <= t) ? acc[r] : 0.f;
            u32x2 w; w.x = cvt_pk_bf16(pv[0], pv[1]); w.y = cvt_pk_bf16(pv[2], pv[3]);
            *(LAS u32x2*)(lds + HG_P + t * 144 + s0 * 2) = w;
        }
    }
    __syncthreads();
    f32x4 acc[4];
#pragma unroll
    for (int tt = 0; tt < 4; ++tt) acc[tt] = (f32x4){0.f, 0.f, 0.f, 0.f};
#pragma unroll
    for (int ks = 0; ks < 4; ++ks) {
        const bf16x8 sf = *(const LAS bf16x8*)(lds + HG_ST + (16 * wave + lr) * 272 + (ks * 32 + 8 * lq) * 2);
#pragma unroll
        for (int tt = 0; tt < 4; ++tt) { const bf16x8 af = *(const LAS bf16x8*)(lds + HG_A1 + (16 * tt + lr) * 272 + (ks * 32 + 8 * lq) * 2);
            acc[tt] = __builtin_amdgcn_mfma_f32_16x16x32_bf16(sf, af, acc[tt], 0, 0, 0); }
    }
#pragma unroll
    for (int ks = 0; ks < 2; ++ks) {
        const bf16x8 vf = *(const LAS bf16x8*)(lds + HG_VT + (16 * wave + lr) * 144 + (ks * 32 + 8 * lq) * 2);
#pragma unroll
        for (int tt = 0; tt < 4; ++tt) { const bf16x8 pf = *(const LAS bf16x8*)(lds + HG_P + (16 * tt + lr) * 144 + (ks * 32 + 8 * lq) * 2);
            acc[tt] = __builtin_amdgcn_mfma_f32_16x16x32_bf16(vf, pf, acc[tt], 0, 0, 0); }
    }
    LAS float* ssq = (LAS float*)(lds + HG_SSQ);
#pragma unroll
    for (int tt = 0; tt < 4; ++tt) { float s = (acc[tt].x * acc[tt].x + acc[tt].y * acc[tt].y) + (acc[tt].z * acc[tt].z + acc[tt].w * acc[tt].w);
        s += __shfl_xor(s, 16); s += __shfl_xor(s, 32); if (lq == 0) ssq[wave * 64 + 16 * tt + lr] = s; }
    __syncthreads();
    {
        const int col = h * 128 + 16 * wave + 4 * lq; const f32x4 hn = *(const f32x4*)(hg_norm + col);
#pragma unroll
        for (int tt = 0; tt < 4; ++tt) { const int t = 16 * tt + lr; float tot = 0.f;
#pragma unroll
            for (int w8 = 0; w8 < 8; ++w8) tot += ssq[w8 * 64 + t];
            const float rinv = rsqrtf(tot * (1.0f / 128.0f) + EPS);
            bf16_t* gp = GS + (size_t)(row0 + t) * HK + col; const u32x2 gw = gpre[tt];
            u32x2 w; w.x = cvt_pk_bf16(acc[tt].x * rinv * hn.x * bf_lo(gw.x), acc[tt].y * rinv * hn.y * bf_hi(gw.x));
            w.y = cvt_pk_bf16(acc[tt].z * rinv * hn.z * bf_lo(gw.y), acc[tt].w * rinv * hn.w * bf_hi(gw.y));
            *(u32x2*)gp = w; }
    }
    __syncthreads();
}

__device__ __forceinline__ void sincos_d(double x, double& s, double& c) {
    const double kq = rint(x * 0.63661977236758134308);
    double r = fma(-kq, 1.57079632679489655800, x); r = fma(-kq, 6.12323399573676603587e-17, r);
    const double r2 = r * r;
    double sp = 1.0 / 6227020800.0; sp = fma(sp, r2, -1.0 / 39916800.0); sp = fma(sp, r2, 1.0 / 362880.0); sp = fma(sp, r2, -1.0 / 5040.0); sp = fma(sp, r2, 1.0 / 120.0); sp = fma(sp, r2, -1.0 / 6.0); sp = fma(sp * r2, r, r);
    double cp = -1.0 / 87178291200.0; cp = fma(cp, r2, 1.0 / 479001600.0); cp = fma(cp, r2, -1.0 / 3628800.0); cp = fma(cp, r2, 1.0 / 40320.0); cp = fma(cp, r2, -1.0 / 720.0); cp = fma(cp, r2, 1.0 / 24.0); cp = fma(cp, r2, -0.5); cp = fma(cp, r2, 1.0);
    const int q = ((int)kq) & 3;
    s = (q == 0) ? sp : (q == 1) ? cp : (q == 2) ? -sp : -cp;
    c = (q == 0) ? cp : (q == 1) ? -sp : (q == 2) ? -cp : sp;
}
struct S5In { const float *lam_re, *lam_im, *log_step, *b_re, *b_im, *c_re, *c_im, *d; };
__device__ __forceinline__ void s5_abar(const S5In& P, int g, int n, float& are, float& aim, float& cr, float& ci) {
    const float lr = P.lam_re[g * NS + n], li = P.lam_im[g * NS + n], dt = expf(P.log_step[g]);
    const float mag = expf(lr * dt); double s, c; sincos_d((double)li * (double)dt, s, c);
    const double ar = (double)mag * c, ai = (double)mag * s;
    are = (float)ar; aim = (float)ai;
    const double nr = ar - 1.0, ni = ai, den = (double)lr * lr + (double)li * li;
    cr = (float)((nr * lr + ni * li) / den); ci = (float)((ni * lr - nr * li) / den);
}
__device__ __forceinline__ void s5_setup(const S5In& P, int g, int lane, float& are, float& aim, float (&bbr)[16], float (&bbi)[16]) {
    float cr, ci; s5_abar(P, g, lane, are, aim, cr, ci);
    const f32x4* br = (const f32x4*)(P.b_re + (size_t)(g * NS + lane) * 16); const f32x4* bi = (const f32x4*)(P.b_im + (size_t)(g * NS + lane) * 16);
#pragma unroll
    for (int q = 0; q < 4; ++q) { const f32x4 r = br[q], i = bi[q];
#pragma unroll
        for (int e = 0; e < 4; ++e) { bbr[q * 4 + e] = cr * r[e] - ci * i[e]; bbi[q * 4 + e] = cr * i[e] + ci * r[e]; } }
}
#define S5_STEP4(uv)                                                                                                     \
    _Pragma("unroll") for (int j = 0; j < 4; ++j) {                                                                      \
        float bur = 0.f, bui = 0.f;                                                                                      \
        _Pragma("unroll") for (int p = 0; p < 16; ++p) { const float up = __int_as_float(__builtin_amdgcn_readlane(__float_as_int(uv), j * 16 + p)); bur = fmaf(up, bbr[p], bur); bui = fmaf(up, bbi[p], bui); } \
        const float nxr = are * xr - aim * xi + bur; xi = are * xi + aim * xr + bui; xr = nxr;                           \
        S5_EMIT(j) }
__device__ __forceinline__ void s5_local_item(const S5In& P, int item, const float* S5U, float* S5E, int lane) {
    const int c = item >> 5, g = item & 31; const int row0 = c == 0 ? MR : 64 * (c - 1), T = c == 0 ? NMETA : 64;
    float are, aim, bbr[16], bbi[16]; s5_setup(P, g, lane, are, aim, bbr, bbi);
    float xr = 0.f, xi = 0.f;
#define S5_EMIT(j)
    float uvs[16];
#pragma unroll
    for (int q = 0; q < 16; ++q) uvs[q] = (4 * q < T) ? S5U[(size_t)(row0 + 4 * q + (lane >> 4)) * S5W + g * 16 + (lane & 15)] : 0.f;
#pragma unroll
    for (int q = 0; q < 16; ++q) { if (4 * q < T) { const float uv = uvs[q]; S5_STEP4(uv) } }
#undef S5_EMIT
    *(float2*)(S5E + ((size_t)c * 2048 + g * NS + lane) * 2) = make_float2(xr, xi);
}
__device__ __forceinline__ float gelu_tanh(float x) { const float u = 0.7978845608028654f * (x + 0.044715f * x * x * x); const float th = 1.0f - 2.0f * __builtin_amdgcn_rcpf(1.0f + __expf(2.0f * u)); return 0.5f * x * (1.0f + th); }
__device__ __forceinline__ void s5_out_item(LAS unsigned char* xs, const S5In& P, int item, const float* S5U, const float* S5E, bf16_t* Z, int lane) {
    const int c = 1 + (item >> 5), g = item & 31, row0 = 64 * (c - 1), lr = lane & 15, lq = lane >> 4;
    float are, aim, bbr[16], bbi[16]; s5_setup(P, g, lane, are, aim, bbr, bbi);
    bf16x8 cf[4];
#pragma unroll
    for (int ks = 0; ks < 4; ++ks) { const float* src = (ks < 2 ? P.c_re : P.c_im) + (size_t)(g * 16 + lr) * NS + (ks & 1) * 32 + 8 * lq; const float sg = ks < 2 ? 1.f : -1.f;
        const f32x4 a = *(const f32x4*)src, b = *(const f32x4*)(src + 4);
        u32x4 w; w.x = cvt_pk_bf16(sg * a.x, sg * a.y); w.y = cvt_pk_bf16(sg * a.z, sg * a.w); w.z = cvt_pk_bf16(sg * b.x, sg * b.y); w.w = cvt_pk_bf16(sg * b.z, sg * b.w);
        cf[ks] = __builtin_bit_cast(bf16x8, w); }
    const f32x4 dk = *(const f32x4*)(P.d + g * 16 + 4 * lq);
    const float2 x0 = *(const float2*)(S5E + ((size_t)c * 2048 + g * NS + lane) * 2);
    float xr = x0.x, xi = x0.y;
    float uvs[16]; f32x4 u4s[4];
#pragma unroll
    for (int q = 0; q < 16; ++q) uvs[q] = S5U[(size_t)(row0 + 4 * q + (lane >> 4)) * S5W + g * 16 + (lane & 15)];
#pragma unroll
    for (int q = 0; q < 4; ++q) u4s[q] = *(const f32x4*)(S5U + (size_t)(row0 + q * 16 + lr) * S5W + g * 16 + 4 * lq);
#pragma unroll
    for (int blk = 0; blk < 4; ++blk) {
#define S5_EMIT(j) { const unsigned pk = cvt_pk_bf16(xr, xi); *(LAS bf16_t*)(xs + (sub * 4 + j) * 272 + lane * 2) = (bf16_t)(pk & 0xffffu); *(LAS bf16_t*)(xs + (sub * 4 + j) * 272 + 128 + lane * 2) = (bf16_t)(pk >> 16); }
#pragma unroll
        for (int sub = 0; sub < 4; ++sub) { const float uv = uvs[blk * 4 + sub]; S5_STEP4(uv) }
#undef S5_EMIT
        LDS_WAIT(); __builtin_amdgcn_wave_barrier();
        f32x4 acc = (f32x4){0.f, 0.f, 0.f, 0.f};
#pragma unroll
        for (int ks = 0; ks < 4; ++ks) { const bf16x8 xf = *(const LAS bf16x8*)(xs + lr * 272 + (ks * 32 + 8 * lq) * 2); acc = __builtin_amdgcn_mfma_f32_16x16x32_bf16(cf[ks], xf, acc, 0, 0, 0); }
        const size_t row = (size_t)(row0 + blk * 16 + lr);
        const f32x4 u4 = u4s[blk];
        u32x2 w; w.x = cvt_pk_bf16(gelu_tanh(acc.x + dk.x * u4.x), gelu_tanh(acc.y + dk.y * u4.y)); w.y = cvt_pk_bf16(gelu_tanh(acc.z + dk.z * u4.z), gelu_tanh(acc.w + dk.w * u4.w));
        *(u32x2*)(Z + row * S5W + g * 16 + 4 * lq) = w;
        LDS_WAIT(); __builtin_amdgcn_wave_barrier();
    }
}

__global__ void __launch_bounds__(512, 2) fwd(Args a) {
    __shared__ __attribute__((aligned(16))) unsigned char lds_raw[LDS_BYTES];
    LAS unsigned char* lds = (LAS unsigned char*)lds_raw;
    const int tid = threadIdx.x, lane = tid & 63, wave = __builtin_amdgcn_readfirstlane(tid >> 6);
    const int G = gridDim.x, bx = blockIdx.x, gw = bx * 8 + wave, NGW = G * 8;
    unsigned char* ws = a.ws;
    const float* x = a.in[0]; const float* meta = a.in[1];
    bf16_t* WGU = (bf16_t*)(ws + WS_WGU); bf16_t* WD = (bf16_t*)(ws + WS_WD); bf16_t* WIN = (bf16_t*)(ws + WS_WIN); bf16_t* WHG = (bf16_t*)(ws + WS_WHG);
    bf16_t* WGLU = (bf16_t*)(ws + WS_WGLU); bf16_t* WOUT = (bf16_t*)(ws + WS_WOUT);
    float* HRES = (float*)(ws + WS_HRES); bf16_t* ABUF = (bf16_t*)(ws + WS_ABUF);
    bf16_t* Qb = (bf16_t*)(ws + WS_Q); bf16_t* Kb = (bf16_t*)(ws + WS_K); float* LOGF = (float*)(ws + WS_LOGF); bf16_t* Vb = (bf16_t*)(ws + WS_V); bf16_t* GS = (bf16_t*)(ws + WS_GS);
    float* S5U = (float*)(ws + WS_S5U); bf16_t* Z = (bf16_t*)(ws + WS_Z); float* PARTA = (float*)(ws + WS_PARTA); float* PARTB = (float*)(ws + WS_PARTB);
    float* DEC = (float*)(ws + WS_DEC); float* S5E = (float*)(ws + WS_S5E); bf16_t* Hh = (bf16_t*)(ws + WS_H); bf16_t* GATES = (bf16_t*)(ws + WS_GATES);
    bf16_t* ST = (bf16_t*)a.out; bf16_t* YS = (bf16_t*)((unsigned char*)a.out + DO_YS); bf16_t* MERGED = (bf16_t*)((unsigned char*)a.out + DO_MERGED);
    S5In s5p{a.in[11], a.in[12], a.in[13], a.in[14], a.in[15], a.in[16], a.in[17], a.in[18]};
    const int lo = a.lo, hi = a.hi;
    cg::grid_group grid = cg::this_grid();
#define IN(k) (lo <= (k) && (k) < hi)
#define SEAM(k) do { if (IN((k) + 1)) grid.sync(); } while (0)
    LAS float* scr = (LAS float*)(lds + wave * 8448);

    if (IN(0)) {
        int it = gw;
        tr_run(TrJob{a.in[3], D, FF, WGU, a.in[2], 1}, it, NGW, scr, lane);
        tr_run(TrJob{a.in[4], D, FF, WGU, a.in[2], 2}, it, NGW, scr, lane);
        tr_run(TrJob{a.in[5], FF, D, WD, nullptr, 0}, it, NGW, scr, lane);
        for (int row = gw; row < MP; row += NGW) {
            const float* src = row < MR ? x + (size_t)row * D : (row < MR + NMETA ? meta + (size_t)(row - MR) * D : nullptr);
            float ss = 0.f;
#pragma unroll
            for (int j = 0; j < 8; ++j) { const f32x4 v = src ? *(const f32x4*)(src + 4 * lane + 256 * j) : (f32x4){0.f, 0.f, 0.f, 0.f};
                ss += (v.x * v.x + v.y * v.y) + (v.z * v.z + v.w * v.w);
                u32x2 w; w.x = cvt_pk_bf16(v.x, v.y); w.y = cvt_pk_bf16(v.z, v.w); *(u32x2*)(ABUF + (size_t)row * D + 4 * lane + 256 * j) = w; }
            ss = wave_sum(ss);
            if (lane < 32) { PARTA[(size_t)row * 32 + lane] = lane == 0 ? ss : 0.f; if (row >= MR) PARTB[(size_t)row * 32 + lane] = 0.f; }
        }
        SEAM(0);
    }
    if (IN(1)) { pg8::Gemm g{ABUF, WGU, MP, 2 * FF, D}; pg8::StaticOrder S; S.init(MP, 2 * FF, G, bx); EpiSwiglu E{Hh, PARTA}; pg8::gemm_phase(lds, g, S, E);
        {
            const int nfull = (MP / 256) * (2 * FF / 256) % G, nfill = nfull ? G - nfull : G;
            if (bx >= nfull || nfull == 0) { const int fb = nfull ? bx - nfull : bx; int it = fb * 8 + wave; const int NW = nfill * 8;
                tr_run(TrJob{a.in[7], D, INCOLS, WIN, a.in[6], 0}, it, NW, scr, lane); }
        }
        SEAM(1); }
    if (IN(2)) { if (bx < D / 16) skinny_down(lds, bx, Hh + (size_t)MR * FF, WD, meta, ABUF, PARTB, wave, lane);
        pg8::Gemm g{Hh, WD, MR, D, FF}; pg8::StaticOrder S; S.init(MR, D, G, bx); EpiRes E{nullptr, x, meta, HRES, ABUF, PARTB, 0.5f, 0}; pg8::gemm_phase(lds, g, S, E); SEAM(2); }
    if (IN(3)) { pg8::Gemm g{ABUF, WIN, MP, NREC, D}; pg8::StaticOrder S; S.init(MP, NREC, G, bx); EpiRec E{Qb, Kb, Vb, GS, LOGF, S5U, PARTB, a.in[8]}; pg8::gemm_phase(lds, g, S, E);
        {
            const int nfull = (MP / 256) * (NREC / 256) % G, nfill = nfull ? G - nfull : G;
            if (bx >= nfull || nfull == 0) { const int fb = nfull ? bx - nfull : bx; int it = fb * 8 + wave; const int NW = nfill * 8;
                tr_run(TrJob{a.in[23], D, FF, WGU, a.in[22], 1}, it, NW, scr, lane);
                tr_run(TrJob{a.in[24], D, FF, WGU, a.in[22], 2}, it, NW, scr, lane);
                tr_run(TrJob{a.in[25], FF, D, WD, nullptr, 0}, it, NW, scr, lane);
                tr_run(TrJob{a.in[10], HK, D, WHG, nullptr, 0}, it, NW, scr, lane);
                tr_run(TrJob{a.in[19], S5W, D, WGLU, nullptr, 1}, it, NW, scr, lane);
                tr_run(TrJob{a.in[20], S5W, D, WGLU, nullptr, 2}, it, NW, scr, lane);
                tr_run(TrJob{a.in[21], D, D, WOUT, nullptr, 0}, it, NW, scr, lane); }
        }
        SEAM(3); }
    if (IN(4)) {
#ifndef DBG_NO_HGL
        for (int item = bx; item < NCH * NH; item += G) hg_local_item(lds, item, LOGF, Kb, Vb, ST, DEC, tid, wave, lane);
#endif
#ifndef DBG_NO_S5L
        for (int item = gw; item < 128 * 32; item += NGW) s5_local_item(s5p, item, S5U, S5E, lane);
#endif
        SEAM(4);
    }
    if (IN(5)) {
        const int gt = bx * 512 + tid;
        if (gt < 98304) {
            unsigned* S32 = (unsigned*)ST; const int e = gt, h = e >> 13, k = (e & 63) * 2;
            float s0 = 0.f, s1 = 0.f;
            for (int cb = 0; cb < 128; cb += 32) {
                unsigned w[32]; float2 d[32];
#pragma unroll
                for (int j = 0; j < 32; ++j) { w[j] = S32[(size_t)(cb + j) * 98304 + e]; d[j] = *(const float2*)(DEC + (size_t)((cb + j) * NH + h) * 128 + k); }
#pragma unroll
                for (int j = 0; j < 32; ++j) { S32[(size_t)(cb + j) * 98304 + e] = cvt_pk_bf16(s0, s1); s0 = fmaf(d[j].x, s0, bf_lo(w[j])); s1 = fmaf(d[j].y, s1, bf_hi(w[j])); }
            }
            S32[(size_t)128 * 98304 + e] = cvt_pk_bf16(s0, s1);
        } else if (gt < 98304 + 2048) {
            const int ch = gt - 98304; float ar, ai, cr, ci; s5_abar(s5p, ch >> 6, ch & 63, ar, ai, cr, ci);
#pragma unroll
            for (int q = 0; q < 6; ++q) { const float nr = ar * ar - ai * ai; ai = 2.f * ar * ai; ar = nr; }
            float xr = 0.f, xi = 0.f;
            for (int cb = 0; cb < 128; cb += 32) {
                float2 ev[32];
#pragma unroll
                for (int j = 0; j < 32; ++j) ev[j] = *(const float2*)(S5E + ((size_t)(cb + j) * 2048 + ch) * 2);
#pragma unroll
                for (int j = 0; j < 32; ++j) { *(float2*)(S5E + ((size_t)(cb + j) * 2048 + ch) * 2) = make_float2(xr, xi);
                    const float nxr = ar * xr - ai * xi + ev[j].x; xi = ar * xi + ai * xr + ev[j].y; xr = nxr; }
            }
            *(float2*)(S5E + ((size_t)128 * 2048 + ch) * 2) = make_float2(xr, xi);
        }
        SEAM(5);
    }
    if (IN(6)) {
        for (int item = bx; item < 128 * NH; item += G) hg_out_item(lds, item, LOGF, Qb, Kb, Vb, ST, GS, a.in[9], tid, wave, lane);
        for (int item = gw; item < 128 * 32; item += NGW) s5_out_item(lds + wave * 4352, s5p, item, S5U, S5E, Z, lane);
        SEAM(6);
    }
    if (IN(7)) {
        { pg8::Gemm g{ABUF, WIN + (size_t)NREC * D, MR, NGATE, D}; pg8::StaticOrder S; S.init(MR, NGATE, G, bx); EpiGates E{GATES, PARTB}; pg8::gemm_phase(lds, g, S, E); }
        { pg8::Gemm g{Z, WGLU, MR, 2 * D, S5W}; pg8::StaticOrder S; S.init(MR, 2 * D, G, bx); EpiGlu E{GATES, YS}; pg8::gemm_phase(lds, g, S, E); }
        SEAM(8); }
    if (IN(9)) { pg8::Gemm g{GS, WHG, MR, D, HK}; pg8::StaticOrder S; S.init(MR, D, G, bx); EpiMerge E{GATES, YS, MERGED}; pg8::gemm_phase(lds, g, S, E); SEAM(9); }
    if (IN(10)) { pg8::Gemm g{MERGED, WOUT, MR, D, D}; pg8::StaticOrder S; S.init(MR, D, G, bx); EpiRes E{HRES, x, meta, HRES, ABUF, PARTA, 1.0f, 1}; pg8::gemm_phase(lds, g, S, E); SEAM(10); }
    if (IN(11)) { pg8::Gemm g{ABUF, WGU, MR, 2 * FF, D}; pg8::StaticOrder S; S.init(MR, 2 * FF, G, bx); EpiSwiglu E{Hh, PARTA}; pg8::gemm_phase(lds, g, S, E); SEAM(11); }
    if (IN(12)) { pg8::Gemm g{Hh, WD, MR, D, FF}; pg8::StaticOrder S; S.init(MR, D, G, bx); EpiRes E{HRES, x, meta, a.out, nullptr, PARTB, 0.5f, 1}; pg8::gemm_phase(lds, g, S, E); SEAM(12); }
    if (IN(13)) {
        const float* gf = a.in[26];
        for (int row = gw; row < MR; row += NGW) {
            const float pv = lane < 32 ? PARTB[(size_t)row * 32 + lane] : 0.f; const float rstd = rsqrtf(wave_sum(pv) * (1.0f / D) + EPS);
            float* o = a.out + (size_t)row * D;
#pragma unroll
            for (int j = 0; j < 8; ++j) { f32x4 v = *(f32x4*)(o + 4 * lane + 256 * j); const f32x4 gg = *(const f32x4*)(gf + 4 * lane + 256 * j);
                v.x *= rstd * gg.x; v.y *= rstd * gg.y; v.z *= rstd * gg.z; v.w *= rstd * gg.w; *(f32x4*)(o + 4 * lane + 256 * j) = v; }
        }
    }
#undef IN
#undef SEAM
}


#ifdef DBG_STOP
struct DbgReg { const unsigned* p; size_t nwords; };
struct DbgArgs { DbgReg r[24]; int n; int pad; unsigned* sums; };
__global__ void dbg_sum(DbgArgs d) {
    for (int i = 0; i < d.n; ++i) { unsigned s = 0; for (size_t w = (size_t)blockIdx.x * blockDim.x + threadIdx.x; w < d.r[i].nwords; w += (size_t)gridDim.x * blockDim.x) s += d.r[i].p[w] * 2654435761u + (unsigned)w;
        for (int o = 1; o < 64; o <<= 1) s += __shfl_xor(s, o);
        if ((threadIdx.x & 63) == 0) atomicAdd(d.sums + i, s); }
}
__global__ void dbg_fill(float* out, const unsigned* sums, int n, size_t total) {
    for (size_t w = (size_t)blockIdx.x * blockDim.x + threadIdx.x; w < total; w += (size_t)gridDim.x * blockDim.x) out[w] = w < (size_t)n ? (float)(sums[w] & 0xFFFFFu) : 0.f;
}
#endif
constexpr int NPHASES = 14;
extern "C" void kernel_launch(void* const* d_in, const int* in_sizes, int n_in, void* d_out, int out_size, void* d_ws, size_t ws_size, hipStream_t stream) {
    static int grid = 0;
    if (grid == 0) {
        if (n_in != 27 || out_size != MR * D || ws_size < WS_END + 256) { fprintf(stderr, "kernel_launch: unexpected shapes (n_in %d out %d ws %zu need %zu)\n", n_in, out_size, ws_size, (size_t)WS_END); grid = -1; return; }
        int dev = 0, cus = 0, per_cu = 0;
        (void)hipGetDevice(&dev); (void)hipDeviceGetAttribute(&cus, hipDeviceAttributeMultiprocessorCount, dev);
        if (hipOccupancyMaxActiveBlocksPerMultiprocessor(&per_cu, (const void*)fwd, 512, 0) != hipSuccess || per_cu < 1) { fprintf(stderr, "kernel_launch: occupancy query gave %d\n", per_cu); per_cu = 1; }
        (void)hipGetLastError();
        grid = cus * 1;
        fprintf(stderr, "kernel_launch: grid %d (cus %d, per_cu %d), ws %zu need %zu\n", grid, cus, per_cu, ws_size, (size_t)WS_END);
    }
    if (grid < 0) return;
    Args a{};
    for (int i = 0; i < 27; ++i) a.in[i] = (const float*)d_in[i];
    a.out = (float*)d_out; a.ws = (unsigned char*)d_ws;
#if MK_MULTI
#ifdef DBG_STOP
    for (int p = 0; p <= DBG_STOP; ++p) { a.lo = p; a.hi = p + 1; hipLaunchKernelGGL(fwd, dim3(grid), dim3(512), 0, stream, a); }
    {
        unsigned char* ws = (unsigned char*)d_ws; DbgArgs d{}; int n = 0;
        auto add = [&](size_t off, size_t bytes) { d.r[n].p = (const unsigned*)(ws + off); d.r[n].nwords = bytes / 4; ++n; };
        const int sel = DBG_SEL;
        if (sel & 1) { add(WS_WGU, (size_t)2 * FF * D * 2); add(WS_WD, (size_t)D * FF * 2); add(WS_WIN, (size_t)INCOLS * D * 2); add(WS_WHG, (size_t)D * HK * 2); add(WS_WGLU, (size_t)2 * D * S5W * 2); add(WS_WOUT, (size_t)D * D * 2); }
        if (sel & 2) { add(WS_HRES, (size_t)MP * D * 4); add(WS_ABUF, (size_t)MP * D * 2); add(WS_PARTB, (size_t)MP * 32 * 4); }
        if (sel & 4) { add(WS_Q, (size_t)MP * HK * 2); add(WS_K, (size_t)MP * HK * 2); add(WS_V, (size_t)MP * HK * 2); add(WS_S5U, (size_t)MP * S5W * 4); }
        if (sel & 8) { add(WS_LOGF, (size_t)(MR + NMETA) * HK * 4); add(WS_DEC, (size_t)128 * NH * 128 * 4); }
        if (sel & 128) { add(WS_S5E, (size_t)128 * 2048 * 8); }
        if (sel & 16) { add(WS_GS, (size_t)MR * HK * 2); add(WS_Z, (size_t)MR * S5W * 2); }
        if (sel & 64) { add(WS_LOGF, (size_t)(MR + NMETA) * HK * 4); add(WS_GS, (size_t)MP * HK * 2); }
        if (sel & 32) { d.r[n].p = (const unsigned*)d_out; d.r[n].nwords = (size_t)128 * NH * 16384 * 2 / 4; ++n; }
        d.n = n; d.sums = (unsigned*)(ws + WS_END);
        hipMemsetAsync(ws + WS_END, 0, 256, stream);
        hipLaunchKernelGGL(dbg_sum, dim3(1024), dim3(256), 0, stream, d);
        hipLaunchKernelGGL(dbg_fill, dim3(1024), dim3(256), 0, stream, (float*)d_out, (const unsigned*)(ws + WS_END), n, (size_t)MR * D);
    }
#else
#ifdef PROBE_SEQ
    { const int seq[] = PROBE_SEQ; for (int i = 0; i < (int)(sizeof(seq) / sizeof(int)); ++i) { a.lo = seq[i]; a.hi = seq[i] + 1; hipLaunchKernelGGL(fwd, dim3(grid), dim3(512), 0, stream, a); } }
#else
    for (int p = 0; p < NPHASES; ++p) { a.lo = p; a.hi = p + 1; hipLaunchKernelGGL(fwd, dim3(grid), dim3(512), 0, stream, a); }
#endif
#endif
#else
    a.lo = 0; a.hi = NPHASES;
    void* args[] = {&a};
    hipError_t e = hipLaunchCooperativeKernel((const void*)fwd, dim3(grid), dim3(512), args, 0, stream);
    if (e != hipSuccess) fprintf(stderr, "kernel_launch: cooperative launch failed: %s (grid %d)\n", hipGetErrorString(e), grid);
#endif
}
```
